# Optimizing an MI355X kernel written in HIP

```python
import math
import jax, jax.numpy as jnp
from jax import lax
import numpy as np

D_MODEL = 2048
BATCH = 4
SEQ = 4096
DEPTH = 1

DA_HEADS = 8
DA_HEAD_DIM = 64
DA_V_DIM = 2 * DA_HEAD_DIM
ROT_DIM = DA_HEAD_DIM // 4
ROPE_THETA = 500000.0
Q_BLOCK = 128
SUBLN_EPS = 1e-5
RW_HEADS = 16
RW_HEAD_DIM = 64
RW_WIDTH = RW_HEADS * RW_HEAD_DIM
DECAY_LORA = 96
AAA_LORA = 96
GATE_LORA = 256
GN_EPS = 64e-5
N_GROUPS = 4
EXPERTS_PER_GROUP = 8
N_EXPERTS = N_GROUPS * EXPERTS_PER_GROUP
TOP_K = 2
D_EXPERT = 1024
ROW_BLOCK = 128
NORM_EPS = 1e-6

DA_QK_WIDTH = DA_HEADS * 2 * DA_HEAD_DIM
DA_V_WIDTH = DA_HEADS * DA_V_DIM
RW_SHIFT_WIDTH = 3 * RW_WIDTH + DECAY_LORA + AAA_LORA + GATE_LORA
IN_SPLITS = (DA_QK_WIDTH, DA_QK_WIDTH, DA_V_WIDTH, RW_SHIFT_WIDTH, D_MODEL, D_MODEL)
IN_WIDTH = sum(IN_SPLITS)
IN_SPLIT_POINTS = [int(v) for v in np.cumsum(IN_SPLITS)[:-1]]
RW_SPLITS = (RW_WIDTH, RW_WIDTH, RW_WIDTH, DECAY_LORA, AAA_LORA, GATE_LORA)
RW_SPLIT_POINTS = [int(v) for v in np.cumsum(RW_SPLITS)[:-1]]

kernel_name = "hybrid_diffattn_rwkv7_hiermoe"


def rms_norm(x, g, eps):
    xf = x.astype(jnp.float32)
    y = xf * lax.rsqrt(jnp.mean(xf * xf, axis=-1, keepdims=True) + eps)
    return (y * g.astype(jnp.float32)).astype(x.dtype)


def rope_tables(seq):
    inv_freq = ROPE_THETA ** (-jnp.arange(0, ROT_DIM, 2, dtype=jnp.float32) / ROT_DIM)
    ang = jnp.arange(seq, dtype=jnp.float32)[:, None] * inv_freq[None, :]
    return jnp.cos(ang), jnp.sin(ang)


def partial_rope(x, cos, sin):
    half = ROT_DIM // 2
    c = cos[None, :, None, None, :].astype(x.dtype)
    s = sin[None, :, None, None, :].astype(x.dtype)
    x1, x2, xp = x[..., :half], x[..., half:ROT_DIM], x[..., ROT_DIM:]
    return jnp.concatenate([x1 * c - x2 * s, x2 * c + x1 * s, xp], axis=-1)


def diff_attention(q, k, v, q_norm_g, k_norm_g, lam_q1, lam_k1, lam_q2, lam_k2,
                   subln_g, lam_init, cos, sin):
    B, S = q.shape[0], q.shape[1]
    nb = S // Q_BLOCK
    q = partial_rope(rms_norm(q, q_norm_g, NORM_EPS), cos, sin) * (DA_HEAD_DIM ** -0.5)
    k = partial_rope(rms_norm(k, k_norm_g, NORM_EPS), cos, sin)
    lam = (jnp.exp(jnp.sum(lam_q1.astype(jnp.float32) * lam_k1.astype(jnp.float32)))
           - jnp.exp(jnp.sum(lam_q2.astype(jnp.float32) * lam_k2.astype(jnp.float32)))
           + lam_init)
    qb = q.reshape(B, nb, Q_BLOCK, DA_HEADS, 2, DA_HEAD_DIM).transpose(1, 0, 3, 4, 2, 5)
    kt = k.transpose(0, 2, 3, 1, 4)
    vt = v.transpose(0, 2, 1, 3)
    kpos = jnp.arange(S)

    def block(args):
        q_blk, i = args
        s = jnp.einsum('bhcqd,bhckd->bhcqk', q_blk, kt).astype(jnp.float32)
        qpos = i * Q_BLOCK + jnp.arange(Q_BLOCK)
        s = jnp.where(kpos[None, :] <= qpos[:, None], s, -jnp.inf)
        p = jax.nn.softmax(s, axis=-1)
        attn = p[:, :, 0] - lam * p[:, :, 1]
        return jnp.einsum('bhqk,bhkd->bhqd', attn.astype(vt.dtype), vt)

    o = lax.map(block, (qb, jnp.arange(nb)))
    o = o.transpose(1, 0, 3, 2, 4).reshape(B, S, DA_HEADS, DA_V_DIM)
    o = rms_norm(o, subln_g, SUBLN_EPS) * (1.0 - lam_init)
    return o.reshape(B, S, DA_V_WIDTH)


def token_shift(z, mu):
    prev = jnp.pad(z, ((0, 0), (1, 0), (0, 0)))[:, :-1]
    return z + (prev - z) * mu


def rwkv7_step(state, inp):
    r_t, w_t, k_t, v_t, a_t, b_t = inp
    sa = jnp.einsum('bhij,bhj->bhi', state, a_t)
    state = (state * w_t[:, :, None, :] + sa[..., None] * b_t[:, :, None, :]
             + v_t[..., None] * k_t[:, :, None, :])
    y = jnp.einsum('bhij,bhj->bhi', state, r_t)
    return state, y


def rwkv7_time_mix(z, w0, w_up, a0, a_up, g_up, k_k, k_a, r_k, lnx_g, lnx_b):
    B, S = z.shape[0], z.shape[1]
    f32 = jnp.float32
    r, k, v, dw, da, dg = jnp.split(z, RW_SPLIT_POINTS, axis=-1)
    w = -jax.nn.softplus(-(w0 + jnp.tanh(dw) @ w_up)) - 0.5
    decay = jnp.exp(-jnp.exp(w.astype(f32)))
    a = jax.nn.sigmoid(a0 + da @ a_up)
    g = jax.nn.sigmoid(dg) @ g_up
    hs = (B, S, RW_HEADS, RW_HEAD_DIM)
    r, k, v, a, decay = (t.reshape(hs).astype(f32) for t in (r, k, v, a, decay))
    kk = k * k_k.reshape(RW_HEADS, RW_HEAD_DIM).astype(f32)
    kk = kk / jnp.maximum(jnp.sqrt(jnp.sum(kk * kk, axis=-1, keepdims=True)), 1e-12)
    k = k * (1.0 + (a - 1.0) * k_a.reshape(RW_HEADS, RW_HEAD_DIM).astype(f32))
    xs = tuple(t.transpose(1, 0, 2, 3) for t in (r, decay, k, v, -kk, kk * a))
    state0 = jnp.zeros((B, RW_HEADS, RW_HEAD_DIM, RW_HEAD_DIM), f32)
    _, ys = lax.scan(rwkv7_step, state0, xs)
    y = ys.transpose(1, 0, 2, 3)
    mu = jnp.mean(y, axis=-1, keepdims=True)
    var = jnp.mean(jnp.square(y - mu), axis=-1, keepdims=True)
    yn = ((y - mu) * lax.rsqrt(var + GN_EPS)).reshape(B, S, RW_WIDTH)
    yn = yn * lnx_g.astype(f32) + lnx_b.astype(f32)
    bonus = jnp.sum(r * k * r_k.astype(f32), axis=-1, keepdims=True) * v
    out = (yn + bonus.reshape(B, S, RW_WIDTH)) * g.astype(f32)
    return out.astype(z.dtype)


def hier_moe(h, router_g, router_g_b, router_e, router_e_b, w_gate_e, w_up_e, w_down_e):
    T, D = h.shape
    f32 = jnp.float32
    p_group = jax.nn.softmax((h @ router_g).astype(f32) + router_g_b.astype(f32), axis=-1)
    p_g_top, g_idx = lax.top_k(p_group, 1)
    e_logits = ((h @ router_e).astype(f32) + router_e_b.astype(f32)).reshape(T, N_GROUPS, EXPERTS_PER_GROUP)
    e_sel = jnp.take_along_axis(e_logits, g_idx[:, :, None], axis=1)[:, 0]
    p_e_top, e_local = lax.top_k(jax.nn.softmax(e_sel, axis=-1), TOP_K)
    gates = p_g_top * p_e_top / jnp.sum(p_e_top, axis=-1, keepdims=True)
    expert = g_idx * EXPERTS_PER_GROUP + e_local

    A = T * TOP_K
    flat_e = expert.reshape(A)
    flat_g = gates.reshape(A)
    flat_t = jnp.repeat(jnp.arange(T, dtype=jnp.int32), TOP_K)
    order = jnp.argsort(flat_e)
    se = flat_e[order]
    counts = jnp.zeros((N_EXPERTS,), jnp.int32).at[flat_e].add(1)
    padded = (counts + ROW_BLOCK - 1) // ROW_BLOCK * ROW_BLOCK
    start = jnp.cumsum(counts) - counts
    pend = jnp.cumsum(padded)
    pstart = pend - padded
    dest = pstart[se] + jnp.arange(A, dtype=jnp.int32) - start[se]
    n_rows = A + N_EXPERTS * ROW_BLOCK
    n_blocks = n_rows // ROW_BLOCK
    row_tok = jnp.zeros((n_rows,), jnp.int32).at[dest].set(flat_t[order])
    row_gate = jnp.zeros((n_rows,), f32).at[dest].set(flat_g[order])
    block_e = jnp.minimum(jnp.searchsorted(pend, jnp.arange(n_blocks, dtype=jnp.int32) * ROW_BLOCK,
                                           side='right'), N_EXPERTS - 1).astype(jnp.int32)

    def expert_block(args):
        tok, e = args
        xb = h[tok]
        return (jax.nn.silu(xb @ w_gate_e[e]) * (xb @ w_up_e[e])) @ w_down_e[e]

    out = lax.map(expert_block, (row_tok.reshape(n_blocks, ROW_BLOCK), block_e))
    contrib = (out.reshape(n_rows, D).astype(f32) * row_gate[:, None]).astype(h.dtype)
    return jnp.zeros_like(h).at[row_tok].add(contrib)


def setup_inputs(seed: int = 0) -> dict:
    key = jax.random.key(seed)
    ks = iter(jax.random.split(key, 48))
    L, D = DEPTH, D_MODEL
    f32 = jnp.float32

    def nrm(shape, scale):
        return jax.random.normal(next(ks), shape, f32) * scale

    def gain(shape):
        return 1.0 + nrm(shape, 0.02)

    def unif(shape, lo, hi):
        return jax.random.uniform(next(ks), shape, f32, lo, hi)

    return {
        "x": nrm((BATCH, SEQ, D), 1.0),
        "norm1_g": gain((L, D)),
        "w_in": nrm((L, D, IN_WIDTH), D ** -0.5),
        "q_norm_g": gain((L, DA_HEAD_DIM)),
        "k_norm_g": gain((L, DA_HEAD_DIM)),
        "lam_q1": nrm((L, DA_HEAD_DIM), 0.1),
        "lam_k1": nrm((L, DA_HEAD_DIM), 0.1),
        "lam_q2": nrm((L, DA_HEAD_DIM), 0.1),
        "lam_k2": nrm((L, DA_HEAD_DIM), 0.1),
        "subln_g": gain((L, DA_V_DIM)),
        "shift_mu": unif((L, RW_SHIFT_WIDTH), 0.0, 1.0),
        "w0": unif((L, RW_WIDTH), -6.0, 1.0),
        "w_up": nrm((L, DECAY_LORA, RW_WIDTH), 0.5 * DECAY_LORA ** -0.5),
        "a0": nrm((L, RW_WIDTH), 0.5),
        "a_up": nrm((L, AAA_LORA, RW_WIDTH), AAA_LORA ** -0.5),
        "g_up": nrm((L, GATE_LORA, RW_WIDTH), GATE_LORA ** -0.5),
        "k_k": 0.85 + nrm((L, RW_WIDTH), 0.05),
        "k_a": 1.0 + nrm((L, RW_WIDTH), 0.05),
        "r_k": nrm((L, RW_HEADS, RW_HEAD_DIM), 0.1),
        "lnx_g": gain((L, RW_WIDTH)),
        "lnx_b": nrm((L, RW_WIDTH), 0.02),
        "proj_a": nrm((L, DA_V_WIDTH, D), DA_V_WIDTH ** -0.5),
        "proj_b": nrm((L, RW_WIDTH, D), RW_WIDTH ** -0.5),
        "w_out": nrm((L, D, D), D ** -0.5),
        "norm2_g": gain((L, D)),
        "router_g": nrm((L, D, N_GROUPS), D ** -0.5),
        "router_g_b": nrm((L, N_GROUPS), 0.01),
        "router_e": nrm((L, D, N_EXPERTS), D ** -0.5),
        "router_e_b": nrm((L, N_EXPERTS), 0.01),
        "w_gate_e": nrm((L, N_EXPERTS, D, D_EXPERT), D ** -0.5),
        "w_up_e": nrm((L, N_EXPERTS, D, D_EXPERT), D ** -0.5),
        "w_down_e": nrm((L, N_EXPERTS, D_EXPERT, D), D_EXPERT ** -0.5),
    }


def reference(x, norm1_g, w_in, q_norm_g, k_norm_g, lam_q1, lam_k1, lam_q2, lam_k2, subln_g,
              shift_mu, w0, w_up, a0, a_up, g_up, k_k, k_a, r_k, lnx_g, lnx_b,
              proj_a, proj_b, w_out, norm2_g, router_g, router_g_b, router_e, router_e_b,
              w_gate_e, w_up_e, w_down_e):
    B, S, D = x.shape
    cos, sin = rope_tables(S)
    for l in range(DEPTH):
        lam_init = 0.8 - 0.6 * math.exp(-0.3 * l)
        h = rms_norm(x, norm1_g[l], NORM_EPS)
        p = h @ w_in[l]
        qa, ka, va, rw, ga, gb = jnp.split(p, IN_SPLIT_POINTS, axis=-1)
        ya = diff_attention(qa.reshape(B, S, DA_HEADS, 2, DA_HEAD_DIM),
                            ka.reshape(B, S, DA_HEADS, 2, DA_HEAD_DIM),
                            va.reshape(B, S, DA_HEADS, DA_V_DIM),
                            q_norm_g[l], k_norm_g[l], lam_q1[l], lam_k1[l], lam_q2[l], lam_k2[l],
                            subln_g[l], lam_init, cos, sin)
        yb = rwkv7_time_mix(token_shift(rw, shift_mu[l]), w0[l], w_up[l], a0[l], a_up[l], g_up[l],
                            k_k[l], k_a[l], r_k[l], lnx_g[l], lnx_b[l])
        merged = jax.nn.sigmoid(ga) * (ya @ proj_a[l]) + jax.nn.sigmoid(gb) * (yb @ proj_b[l])
        x = x + merged @ w_out[l]
        h2 = rms_norm(x, norm2_g[l], NORM_EPS).reshape(B * S, D)
        x = x + hier_moe(h2, router_g[l], router_g_b[l], router_e[l], router_e_b[l],
                         w_gate_e[l], w_up_e[l], w_down_e[l]).reshape(B, S, D)
    return x
```

```cpp
#include <hip/hip_runtime.h>
#include <hip/hip_bf16.h>
#include <cstdio>
#include <cstdint>
#include <cmath>

#ifndef DBG_ACC
#define DBG_ACC(x) (x)
#endif
#ifndef MK_SPLIT
#define MK_SPLIT 0
#endif

namespace pg8 {
#define PG8_LAS __attribute__((address_space(3)))
typedef unsigned short bf16_t;
typedef short bf16x8 __attribute__((ext_vector_type(8)));
typedef float f32x4 __attribute__((ext_vector_type(4)));
typedef unsigned u32x4 __attribute__((ext_vector_type(4)));
constexpr int BM = 256, BK = 64, HALF = 128, HTB = HALF * BK * 2  , STAGE_BYTES = 8 * HTB, NXCD = 8, WGM = 8;

__host__ __device__ __forceinline__ int lds_byte(int r, int c) { const int st = (r >> 4) * 2 + (c >> 5), rr = r & 15, cc = c & 31, ob = rr * 64 + cc * 2; return st * 1024 + (ob ^ (((ob >> 9) & 1) << 5)); }
__host__ __device__ __forceinline__ void stage_rc(int b, int& R, int& C) { const int st = b / 1024, sb = b % 1024, swz = sb ^ (((sb >> 9) & 1) << 5); R = (st >> 1) * 16 + swz / 64; C = (st & 1) * 32 + (swz % 64) / 2; }
__host__ __device__ __forceinline__ int perm32(int rho) { const int n = rho >> 4, i = rho & 15; return 8 * (i >> 2) + 4 * n + (i & 3); }

struct Unit { int pm, pn, pb, ko; };
struct Gemm { const bf16_t* A; const bf16_t* Bt; int K, ld; };

struct StaticOrder {
    int nM, nN, nwg, G, c;
    __host__ __device__ void init(int M, int N, int G_, int c_) { nM = M / BM; nN = N / BM; nwg = nM * nN; G = G_; c = c_; }
    __host__ __device__ bool next(int i, Unit& u) const {
        const long L = (long)i * G + c; if (L >= nwg) return false;
        int wgid = (int)L; { const int q = nwg / NXCD, r = nwg % NXCD, xcd = wgid % NXCD, off = wgid / NXCD; wgid = (xcd < r ? xcd * (q + 1) : r * (q + 1) + (xcd - r) * q) + off; }
        const int nig = WGM * nN, gid = wgid / nig, fm = gid * WGM, gsz = (nM - fm) < WGM ? (nM - fm) : WGM;
        u.pm = fm + ((wgid % nig) % gsz); u.pn = (wgid % nig) / gsz; u.pb = u.pn; u.ko = 0; return true;
    }
};
struct LoraOrder {
    StaticOrder so;
    __device__ __forceinline__ bool next(int i, Unit& u) const { if (!so.next(i, u)) return false; u.pb = (u.pm >> 6) * 4 + u.pn; return true; }
};
struct RouterOrder {
    int G, c;
    __device__ __forceinline__ bool next(int i, Unit& u) const { const int L = i * G + c; if (L >= 256) return false; u.pm = L >> 2; u.pn = 0; u.pb = 0; u.ko = (L & 3) * 512; return true; }
};
struct MoeOrder {
    StaticOrder so; const PG8_LAS int* tile_e;
    __device__ __forceinline__ bool next(int i, Unit& u) const { if (!so.next(i, u)) return false; u.pb = tile_e[u.pm] * 8 + u.pn; return true; }
};

typedef float f32x2_t __attribute__((ext_vector_type(2))); typedef __bf16 bf16x2_t __attribute__((ext_vector_type(2)));
__device__ __forceinline__ unsigned cvt_pk_bf16(float lo, float hi) { f32x2_t v = {lo, hi}; bf16x2_t b = __builtin_convertvector(v, bf16x2_t); return __builtin_bit_cast(unsigned, b); }
__device__ __forceinline__ float bf_lo(unsigned w) { return __uint_as_float(w << 16); }
__device__ __forceinline__ float bf_hi(unsigned w) { return __uint_as_float(w & 0xffff0000u); }
__device__ __forceinline__ float sigmoidf_(float x) { return __builtin_amdgcn_rcpf(1.0f + __expf(-x)); }
__device__ __forceinline__ u32x4 pack8(const f32x4 v0, const f32x4 v1) { u32x4 w; w.x = cvt_pk_bf16(v0[0], v0[1]); w.y = cvt_pk_bf16(v0[2], v0[3]); w.z = cvt_pk_bf16(v1[0], v1[1]); w.w = cvt_pk_bf16(v1[2], v1[3]); return w; }
__device__ __forceinline__ void unpack8(const u32x4 w, f32x4& v0, f32x4& v1) { v0 = (f32x4){bf_lo(w.x), bf_hi(w.x), bf_lo(w.y), bf_hi(w.y)}; v1 = (f32x4){bf_lo(w.z), bf_hi(w.z), bf_lo(w.w), bf_hi(w.w)}; }

#define PG8_EPI_LOOP_BEGIN \
    _Pragma("unroll") for (int ai = 0; ai < 2; ++ai) _Pragma("unroll") for (int m = 0; m < 4; ++m) { const int row = u.pm * BM + ai * HALF + wr * 64 + m * 16 + fr; \
        _Pragma("unroll") for (int bj = 0; bj < 2; ++bj) { const int colr = bj * HALF + wc * 32 + 8 * fq; f32x4 v0 = acc[ai][bj][m][0], v1 = acc[ai][bj][m][1];
#define PG8_EPI_LOOP_END } }

struct EpiWin {
    static constexpr bool PERM = true;
    bf16_t *Q, *K, *V, *RW, *G;
    __device__ __forceinline__ void operator()(const f32x4 (&acc)[2][2][4][2], const Unit& u, int wr, int wc, int fr, int fq) const {
        bf16_t* base; int ldc, colt; const int pn = u.pn;
        if (pn < 4) { base = Q; ldc = 1024; colt = pn * 256; } else if (pn < 8) { base = K; ldc = 1024; colt = (pn - 4) * 256; } else if (pn < 12) { base = V; ldc = 1024; colt = (pn - 8) * 256; }
        else if (pn < 26) { base = RW; ldc = 3584; colt = (pn - 12) * 256; } else { base = G; ldc = 4096; colt = (pn - 26) * 256; }
        PG8_EPI_LOOP_BEGIN
            *(u32x4*)(base + (size_t)row * ldc + colt + colr) = pack8(v0, v1);
        PG8_EPI_LOOP_END
    }
};
struct EpiLora {
    static constexpr bool PERM = true;
    float* LD; bf16_t* AS; bf16_t* GG; const float* w0; const float* a0;
    __device__ __forceinline__ void operator()(const f32x4 (&acc)[2][2][4][2], const Unit& u0, int wr, int wc, int fr, int fq) const {
        const int which = u0.pm >> 6; Unit u = u0; u.pm = u0.pm & 63; const int colt = u.pn * 256;
        PG8_EPI_LOOP_BEGIN
            const int col = colt + colr; const size_t off = (size_t)row * 1024 + col;
            if (which == 0) { const f32x4 b0 = *(const f32x4*)(w0 + col), b1 = *(const f32x4*)(w0 + col + 4); f32x4 o0, o1;
#pragma unroll
                for (int j = 0; j < 4; ++j) { float z = -(v0[j] + b0[j]); float sp = fmaxf(z, 0.f) + __logf(1.0f + __expf(-fabsf(z))); o0[j] = -__expf(-sp - 0.5f);
                                              z = -(v1[j] + b1[j]); sp = fmaxf(z, 0.f) + __logf(1.0f + __expf(-fabsf(z))); o1[j] = -__expf(-sp - 0.5f); }
                *(f32x4*)(LD + off) = o0; *(f32x4*)(LD + off + 4) = o1; }
            else if (which == 1) { const f32x4 b0 = *(const f32x4*)(a0 + col), b1 = *(const f32x4*)(a0 + col + 4);
#pragma unroll
                for (int j = 0; j < 4; ++j) { v0[j] = sigmoidf_(DBG_ACC(v0[j]) + b0[j]); v1[j] = sigmoidf_(DBG_ACC(v1[j]) + b1[j]); }
                *(u32x4*)(AS + off) = pack8(v0, v1); }
            else { *(u32x4*)(GG + off) = pack8(v0, v1); }
        PG8_EPI_LOOP_END
    }
};
template <int MODE> struct EpiProj {
    static constexpr bool PERM = true;
    const bf16_t* G; int goff; bf16_t* TMP; bf16_t* OUT;
    __device__ __forceinline__ void operator()(const f32x4 (&acc)[2][2][4][2], const Unit& u, int wr, int wc, int fr, int fq) const {
        const int colt = u.pn * 256;
        PG8_EPI_LOOP_BEGIN
            const int col = colt + colr; const u32x4 gw = *(const u32x4*)(G + (size_t)row * 4096 + goff + col); f32x4 g0, g1; unpack8(gw, g0, g1);
#pragma unroll
            for (int j = 0; j < 4; ++j) { v0[j] *= sigmoidf_(g0[j]); v1[j] *= sigmoidf_(g1[j]); }
#ifdef DBG_NO_YA
            if (MODE == 0) { v0 *= 0.f; v1 *= 0.f; }
#endif
#ifdef DBG_NO_YB
            if (MODE == 1) { v0 *= 0.f; v1 *= 0.f; }
#endif
            if (MODE == 1) { const u32x4 tw = *(const u32x4*)(TMP + (size_t)row * 2048 + col); f32x4 t0, t1; unpack8(tw, t0, t1); v0 += t0; v1 += t1; *(u32x4*)(OUT + (size_t)row * 2048 + col) = pack8(v0, v1); }
            else *(u32x4*)(TMP + (size_t)row * 2048 + col) = pack8(v0, v1);
        PG8_EPI_LOOP_END
    }
};
struct EpiRes {
    static constexpr bool PERM = true;
    const float* X; float* O;
    __device__ __forceinline__ void operator()(const f32x4 (&acc)[2][2][4][2], const Unit& u, int wr, int wc, int fr, int fq) const {
        const int colt = u.pn * 256;
        PG8_EPI_LOOP_BEGIN
            const size_t off = (size_t)row * 2048 + colt + colr;
            *(f32x4*)(O + off) = v0 + *(const f32x4*)(X + off); *(f32x4*)(O + off + 4) = v1 + *(const f32x4*)(X + off + 4);
        PG8_EPI_LOOP_END
    }
};
struct EpiRouter {
    static constexpr bool PERM = true;
    float* LG;
    __device__ __forceinline__ void operator()(const f32x4 (&acc)[2][2][4][2], const Unit& u, int wr, int wc, int fr, int fq) const {
        float* base = LG + (size_t)(u.ko >> 9) * 16384 * 64;
        PG8_EPI_LOOP_BEGIN
            if (bj == 0 && wc < 2) { float* p = base + (size_t)row * 64 + colr; *(f32x4*)p = v0; *(f32x4*)(p + 4) = v1; }
        PG8_EPI_LOOP_END
    }
};
struct EpiGU {
    static constexpr bool PERM = true;
    bf16_t* ACT;
    __device__ __forceinline__ void operator()(const f32x4 (&acc)[2][2][4][2], const Unit& u, int wr, int wc, int fr, int fq) const {
#pragma unroll
        for (int ai = 0; ai < 2; ++ai)
#pragma unroll
            for (int m = 0; m < 4; ++m) { const int row = u.pm * BM + ai * HALF + wr * 64 + m * 16 + fr; const int col = u.pn * 128 + wc * 32 + 8 * fq;
                f32x4 g0 = acc[ai][0][m][0], g1 = acc[ai][0][m][1]; const f32x4 u0 = acc[ai][1][m][0], u1 = acc[ai][1][m][1];
#pragma unroll
                for (int j = 0; j < 4; ++j) { g0[j] = g0[j] * sigmoidf_(g0[j]) * u0[j]; g1[j] = g1[j] * sigmoidf_(g1[j]) * u1[j]; }
                *(u32x4*)(ACT + (size_t)row * 1024 + col) = pack8(g0, g1); }
    }
};
struct EpiDown {
    static constexpr bool PERM = true;
    bf16_t* YD; const float* gate;
    __device__ __forceinline__ void operator()(const f32x4 (&acc)[2][2][4][2], const Unit& u, int wr, int wc, int fr, int fq) const {
        const int colt = u.pn * 256;
        PG8_EPI_LOOP_BEGIN
            const float gt = gate[row]; v0 *= gt; v1 *= gt;
            *(u32x4*)(YD + (size_t)row * 2048 + colt + colr) = pack8(v0, v1);
        PG8_EPI_LOOP_END
    }
};

template <class Epi, class Sched, bool ALIGN_EPI = false, bool SP2 = false>
__device__ __forceinline__ void gemm_phase(PG8_LAS unsigned char* lds, const Gemm g, const Sched& S, const Epi& E) {
    const int tid = threadIdx.x, wid = __builtin_amdgcn_readfirstlane(tid >> 6), lane = tid & 63, wr = wid >> 2, wc = wid & 3, fr = lane & 15, fq = lane >> 4;
    const int K = g.K, nt = K / BK, LD = g.ld;
    unsigned voffA[2], voffB[2];
#pragma unroll
    for (int i = 0; i < 2; ++i) { int R, C; stage_rc(tid * 16 + i * 8192, R, C); const int Rb = Epi::PERM ? ((R & ~31) + perm32(R & 31)) : R;
        voffA[i] = (unsigned)(R * LD + C) * 2u; voffB[i] = (unsigned)(Rb * LD + C) * 2u; }
    const size_t kstep = (size_t)(BK * 2);
    const size_t hstep = (size_t)HALF * LD * 2;
    const size_t tstep = 2 * hstep;
    const unsigned ldsw = (unsigned)wid * 1024u;
    const int aoff = lds_byte(wr * 64 + fr, fq * 8), boff = lds_byte(wc * 32 + fr, fq * 8);
#define PG8_SA(b, h) (((b) * 2 + (h)) * HTB)
#define PG8_SB(b, h) ((4 + (b) * 2 + (h)) * HTB)
#define PG8_STAGE(bufoff, gbase, voff) do { _Pragma("unroll") for (int _i = 0; _i < 2; ++_i) \
        __builtin_amdgcn_global_load_lds((const unsigned*)((const char*)(gbase) + (voff)[_i]), (PG8_LAS unsigned*)(lds + (bufoff) + ldsw + _i * 8192), 16, 0, 0); } while (0)
#define PG8_LDA(dst, b, h) do { _Pragma("unroll") for (int m = 0; m < 4; ++m) _Pragma("unroll") for (int k = 0; k < 2; ++k) dst[m][k] = *(const PG8_LAS bf16x8*)(lds + PG8_SA(b, h) + aoff + m * 2048 + k * 1024); } while (0)
#define PG8_LDB(dst, b, h) do { _Pragma("unroll") for (int n = 0; n < 2; ++n) _Pragma("unroll") for (int k = 0; k < 2; ++k) dst[n][k] = *(const PG8_LAS bf16x8*)(lds + PG8_SB(b, h) + boff + n * 2048 + k * 1024); } while (0)
#define PG8_MMA(ai, bj, At, Bt) do { __builtin_amdgcn_s_setprio(1); _Pragma("unroll") for (int m = 0; m < 4; ++m) _Pragma("unroll") for (int n = 0; n < 2; ++n) _Pragma("unroll") for (int k = 0; k < 2; ++k) \
        acc[ai][bj][m][n] = __builtin_amdgcn_mfma_f32_16x16x32_bf16(Bt[n][k], At[m][k], acc[ai][bj][m][n], 0, 0, 0); __builtin_amdgcn_s_setprio(0); } while (0)
#define PG8_WAIT_V(n) asm volatile("s_waitcnt vmcnt(" #n ")" ::: "memory")
#define PG8_WAIT_L(n) asm volatile("s_waitcnt lgkmcnt(" #n ")" ::: "memory")
#define PG8_BAR __builtin_amdgcn_s_barrier()
#define PG8_SCHED __builtin_amdgcn_sched_barrier(0)
    Unit cur, nxt; int ui = 0;
    if (!S.next(0, cur)) return;
    f32x4 acc[2][2][4][2];
#pragma unroll
    for (int a = 0; a < 2; ++a)
#pragma unroll
        for (int b = 0; b < 2; ++b)
#pragma unroll
            for (int m = 0; m < 4; ++m)
#pragma unroll
                for (int n = 0; n < 2; ++n) acc[a][b][m][n] = (f32x4){0.f, 0.f, 0.f, 0.f};
    bf16x8 At[4][2], B0[2][2], B1[2][2];
    const char* cA = (const char*)g.A + (size_t)cur.pm * tstep + (size_t)cur.ko * 2; const char* cB = (const char*)g.Bt + (size_t)cur.pb * tstep + (size_t)cur.ko * 2;
    if constexpr (SP2) {
        PG8_STAGE(PG8_SB(0, 0), cB, voffB); PG8_STAGE(PG8_SB(0, 1), cB + hstep, voffB); PG8_STAGE(PG8_SA(0, 0), cA, voffA); PG8_STAGE(PG8_SA(0, 1), cA + hstep, voffA);
        if (wr == 1) PG8_BAR;
        PG8_WAIT_V(2); PG8_BAR;
        PG8_STAGE(PG8_SB(1, 0), cB + kstep, voffB); PG8_STAGE(PG8_SA(1, 0), cA + kstep, voffA); PG8_STAGE(PG8_SB(1, 1), cB + hstep + kstep, voffB);
        PG8_WAIT_V(6); PG8_BAR;
    } else {
        PG8_STAGE(PG8_SB(0, 0), cB, voffB); PG8_STAGE(PG8_SA(0, 0), cA, voffA); PG8_STAGE(PG8_SB(0, 1), cB + hstep, voffB); PG8_STAGE(PG8_SA(0, 1), cA + hstep, voffA);
        if (wr == 1) PG8_BAR;
        PG8_WAIT_V(4); PG8_BAR;
        PG8_STAGE(PG8_SB(1, 0), cB + kstep, voffB); PG8_STAGE(PG8_SA(1, 0), cA + kstep, voffA); PG8_STAGE(PG8_SB(1, 1), cB + hstep + kstep, voffB);
        PG8_WAIT_V(6); PG8_BAR;
    }
    for (;;) {
        const bool has_next = S.next(ui + 1, nxt);
        const char* nA = has_next ? (const char*)g.A + (size_t)nxt.pm * tstep + (size_t)nxt.ko * 2 : cA; const char* nB = has_next ? (const char*)g.Bt + (size_t)nxt.pb * tstep + (size_t)nxt.ko * 2 : cB;
        for (int t = 0; t < nt; t += 2) {
            const bool last = (t == nt - 2);
            const char* a1 = cA + (size_t)(t + 1) * kstep;
            const char* a2 = last ? nA : cA + (size_t)(t + 2) * kstep; const char* b2 = last ? nB : cB + (size_t)(t + 2) * kstep;
            const char* a3 = a2 + kstep; const char* b3 = b2 + kstep;
            if constexpr (SP2) {
            PG8_LDB(B0, 0, 0); PG8_LDB(B1, 0, 1); PG8_SCHED; PG8_LDA(At, 0, 0); PG8_STAGE(PG8_SA(1, 1), a1 + hstep, voffA);
            PG8_WAIT_V(8); PG8_WAIT_L(0); PG8_BAR; PG8_MMA(0, 0, At, B0); PG8_MMA(0, 1, At, B1); PG8_BAR; PG8_SCHED;
            PG8_LDA(At, 0, 1); PG8_STAGE(PG8_SB(0, 0), b2, voffB); PG8_STAGE(PG8_SB(0, 1), b2 + hstep, voffB); PG8_STAGE(PG8_SA(0, 0), a2, voffA);
            PG8_WAIT_V(8); PG8_WAIT_L(0); PG8_BAR; PG8_MMA(1, 0, At, B0); PG8_MMA(1, 1, At, B1); PG8_BAR; PG8_SCHED;
            PG8_LDB(B0, 1, 0); PG8_LDB(B1, 1, 1); PG8_SCHED; PG8_LDA(At, 1, 0); PG8_STAGE(PG8_SA(0, 1), a2 + hstep, voffA);
            PG8_WAIT_V(8); PG8_WAIT_L(0); PG8_BAR; PG8_MMA(0, 0, At, B0); PG8_MMA(0, 1, At, B1); PG8_BAR; PG8_SCHED;
            PG8_LDA(At, 1, 1); PG8_STAGE(PG8_SB(1, 0), b3, voffB); PG8_STAGE(PG8_SB(1, 1), b3 + hstep, voffB); PG8_STAGE(PG8_SA(1, 0), a3, voffA);
            PG8_WAIT_V(8); PG8_WAIT_L(0); PG8_BAR; PG8_MMA(1, 0, At, B0); PG8_MMA(1, 1, At, B1); PG8_BAR; PG8_SCHED;
            } else {
            PG8_LDB(B0, 0, 0); PG8_SCHED; PG8_LDA(At, 0, 0); PG8_STAGE(PG8_SA(1, 1), a1 + hstep, voffA);
            PG8_WAIT_L(8); PG8_BAR; PG8_WAIT_L(0); PG8_MMA(0, 0, At, B0); PG8_BAR; PG8_SCHED;
            PG8_LDB(B1, 0, 1); PG8_STAGE(PG8_SB(0, 0), b2, voffB);
            PG8_BAR; PG8_WAIT_L(0); PG8_MMA(0, 1, At, B1); PG8_BAR;
            PG8_LDA(At, 0, 1); PG8_STAGE(PG8_SA(0, 0), a2, voffA);
            PG8_BAR; PG8_WAIT_L(0); PG8_MMA(1, 0, At, B0); PG8_BAR; PG8_SCHED;
            PG8_STAGE(PG8_SB(0, 1), b2 + hstep, voffB);
            PG8_WAIT_V(6); PG8_BAR; PG8_MMA(1, 1, At, B1); PG8_BAR;
            PG8_LDB(B0, 1, 0); PG8_SCHED; PG8_LDA(At, 1, 0); PG8_STAGE(PG8_SA(0, 1), a2 + hstep, voffA);
            PG8_WAIT_L(8); PG8_BAR; PG8_WAIT_L(0); PG8_MMA(0, 0, At, B0); PG8_BAR; PG8_SCHED;
            PG8_LDB(B1, 1, 1); PG8_STAGE(PG8_SB(1, 0), b3, voffB);
            PG8_BAR; PG8_WAIT_L(0); PG8_MMA(0, 1, At, B1); PG8_BAR;
            PG8_LDA(At, 1, 1); PG8_STAGE(PG8_SA(1, 0), a3, voffA);
            PG8_BAR; PG8_WAIT_L(0); PG8_MMA(1, 0, At, B0); PG8_BAR; PG8_SCHED;
            PG8_STAGE(PG8_SB(1, 1), b3 + hstep, voffB);
            PG8_WAIT_V(6); PG8_BAR; PG8_MMA(1, 1, At, B1); PG8_BAR;
            }
        }
        if constexpr (ALIGN_EPI) { if (wr == 0) PG8_BAR; }
        E(acc, cur, wr, wc, fr, fq);
        if (!has_next) break;
#pragma unroll
        for (int a = 0; a < 2; ++a)
#pragma unroll
            for (int b = 0; b < 2; ++b)
#pragma unroll
                for (int m = 0; m < 4; ++m)
#pragma unroll
                    for (int n = 0; n < 2; ++n) acc[a][b][m][n] = (f32x4){0.f, 0.f, 0.f, 0.f};
        cur = nxt; cA = nA; cB = nB; ++ui;
        if constexpr (ALIGN_EPI) { if (wr == 1) PG8_BAR; }
    }
    PG8_WAIT_V(0);
    if constexpr (!ALIGN_EPI) { if (wr == 0) PG8_BAR; }
    PG8_BAR;
#undef PG8_SA
#undef PG8_SB
#undef PG8_STAGE
#undef PG8_LDA
#undef PG8_LDB
#undef PG8_MMA
#undef PG8_WAIT_V
#undef PG8_WAIT_L
#undef PG8_BAR
#undef PG8_SCHED
}
}


#include <hip/hip_bf16.h>
#include <cmath>
namespace attn_body {
using bf16=__hip_bfloat16;
using bf16x8=__attribute__((ext_vector_type(8)))short;
using s16x4=__attribute__((ext_vector_type(4)))short;
using f32x16=__attribute__((ext_vector_type(16)))float;
using u32x4=__attribute__((ext_vector_type(4)))unsigned;
constexpr int SEQ=4096,D=64,DM=1024,ODM=2048;
constexpr int NW=8,QBLK=32,QB=QBLK*NW,KVBLK=64,NQB=SEQ/QB;
__device__ __forceinline__ int crow(int r,int hi){return (r&3)+8*(r>>2)+4*hi;}
#define SBAR() __builtin_amdgcn_sched_barrier(0)
__device__ __forceinline__ void cmask(f32x16&p0,f32x16&p1,int jb,int qrel,int hi){
  const float NEG=-INFINITY; int kb=64*jb+4*hi;
  #pragma unroll
  for(int r=0;r<16;++r){int kv=kb+(r&3)+8*(r>>2); if(kv>qrel)p0[r]=NEG; if(kv+32>qrel)p1[r]=NEG;}
}

constexpr int NSLOT=3, SLOTB=8192;
constexpr int LDS_K=0, LDS_V=NSLOT*SLOTB, LDS_WS=2*NSLOT*SLOTB, LDS_OST=LDS_WS+NW*64*4, LDS_BYTES=LDS_OST+NW*4096;
constexpr float C2=0.125f*1.4426950408889634f;
__device__ __forceinline__ void glds16(const void*gsrc,unsigned lds_dst){unsigned keep;
  asm volatile("s_mov_b32 %0, m0\n\ts_mov_b32 m0, %2\n\ts_nop 0\n\tglobal_load_lds_dwordx4 %1, off\n\ts_mov_b32 m0, %0":"=&s"(keep):"v"(gsrc),"s"(lds_dst):"memory");}
__device__ __forceinline__ float max3f(float a,float b,float c){float r;asm("v_max3_f32 %0, %1, %2, %3":"=v"(r):"v"(a),"v"(b),"v"(c));return r;}
__device__ __forceinline__ float max2f(float a,float b){float r;asm("v_max_f32_e32 %0, %1, %2":"=v"(r):"v"(a),"v"(b));return r;}
__device__ __forceinline__ float fadd_s(float a,float b){float r;asm("v_add_f32_e32 %0, %1, %2":"=v"(r):"v"(a),"v"(b));return r;}
__device__ __forceinline__ float fsub_s(float a,float b){float r;asm("v_sub_f32_e32 %0, %1, %2":"=v"(r):"v"(a),"v"(b));return r;}
typedef float f32x2_t __attribute__((ext_vector_type(2))); typedef __bf16 bf16x2_t __attribute__((ext_vector_type(2)));
__device__ __forceinline__ unsigned cvtpk_s(float lo,float hi){f32x2_t v={lo,hi};bf16x2_t b=__builtin_convertvector(v,bf16x2_t);return __builtin_bit_cast(unsigned,b);}
#define WAIT_BAR(N) asm volatile("s_waitcnt vmcnt(" #N ") lgkmcnt(0)\n\ts_barrier":::"memory")

__device__ __forceinline__ void qkt(f32x16&p0,f32x16&p1,const char*Kslot,const bf16x8*qr,const f32x16&negm,int r32,int hi){
  const char*kb=Kslot+hi*1024+r32*16;
  #pragma unroll
  for(int d0=0;d0<4;++d0){
    const bf16x8 b0=*reinterpret_cast<const bf16x8*>(kb+d0*2048);
    const bf16x8 b1=*reinterpret_cast<const bf16x8*>(kb+d0*2048+512);
    if(d0==0){p0=__builtin_amdgcn_mfma_f32_32x32x16_bf16(b0,qr[0],negm,0,0,0);p1=__builtin_amdgcn_mfma_f32_32x32x16_bf16(b1,qr[0],negm,0,0,0);}
    else{p0=__builtin_amdgcn_mfma_f32_32x32x16_bf16(b0,qr[d0],p0,0,0,0);p1=__builtin_amdgcn_mfma_f32_32x32x16_bf16(b1,qr[d0],p1,0,0,0);}}
}
typedef __attribute__((address_space(3))) const char* lds_cptr;
typedef short v4i16_t __attribute__((ext_vector_type(4)));
__device__ __forceinline__ void kload8(bf16x8*kf,lds_cptr kp){
  kf[0]=*(const __attribute__((address_space(3))) bf16x8*)(kp);      kf[1]=*(const __attribute__((address_space(3))) bf16x8*)(kp+512);
  kf[2]=*(const __attribute__((address_space(3))) bf16x8*)(kp+2048); kf[3]=*(const __attribute__((address_space(3))) bf16x8*)(kp+2560);
  kf[4]=*(const __attribute__((address_space(3))) bf16x8*)(kp+4096); kf[5]=*(const __attribute__((address_space(3))) bf16x8*)(kp+4608);
  kf[6]=*(const __attribute__((address_space(3))) bf16x8*)(kp+6144); kf[7]=*(const __attribute__((address_space(3))) bf16x8*)(kp+6656);
}
__device__ __forceinline__ void kload2(bf16x8*kf,lds_cptr kp,int j){ kf[2*j]=*(const __attribute__((address_space(3))) bf16x8*)(kp+j*2048); kf[2*j+1]=*(const __attribute__((address_space(3))) bf16x8*)(kp+j*2048+512); }
__device__ __forceinline__ s16x4 vtr(lds_cptr p){ return __builtin_bit_cast(s16x4,__builtin_amdgcn_ds_read_tr16_b64_v4i16((__attribute__((address_space(3))) v4i16_t*)p)); }
__device__ __forceinline__ float rowmax(const f32x16&p0,const f32x16&p1){
  float a=max3f(p0[0],p0[1],p1[0]),b=max3f(p0[2],p0[3],p1[1]);a=max3f(a,p1[2],p1[3]);
  #pragma unroll
  for(int r=4;r<16;r+=4){a=max3f(a,p0[r],p0[r+1]);b=max3f(b,p0[r+2],p0[r+3]);a=max3f(a,p1[r],p1[r+1]);b=max3f(b,p1[r+2],p1[r+3]);}
  const float m=max2f(a,b);
  auto rr=__builtin_amdgcn_permlane32_swap(__float_as_uint(m),__float_as_uint(m),false,false);
  return max2f(__uint_as_float(rr[0]),__uint_as_float(rr[1]));
}
__device__ __forceinline__ void pv(f32x16*o,int vb,bf16x8 pa0,bf16x8 pa1,bf16x8 pa2,bf16x8 pa3){
  #pragma unroll
  for(int d0=0;d0<2;++d0){s16x4 lo[4],hi[4];
    #pragma unroll
    for(int ks=0;ks<4;++ks){
      asm volatile("ds_read_b64_tr_b16 %0,%1 offset:%c2":"=&v"(lo[ks]):"v"(vb),"i"(d0*4096+ks*1024):"memory");
      asm volatile("ds_read_b64_tr_b16 %0,%1 offset:%c2":"=&v"(hi[ks]):"v"(vb),"i"(d0*4096+ks*1024+512):"memory");}
    asm volatile("s_waitcnt lgkmcnt(0)":::"memory");SBAR();
    #define PK(k) (bf16x8){lo[k][0],lo[k][1],lo[k][2],lo[k][3],hi[k][0],hi[k][1],hi[k][2],hi[k][3]}
    o[d0]=__builtin_amdgcn_mfma_f32_32x32x16_bf16(pa0,PK(0),o[d0],0,0,0);
    o[d0]=__builtin_amdgcn_mfma_f32_32x32x16_bf16(pa1,PK(1),o[d0],0,0,0);
    o[d0]=__builtin_amdgcn_mfma_f32_32x32x16_bf16(pa2,PK(2),o[d0],0,0,0);
    o[d0]=__builtin_amdgcn_mfma_f32_32x32x16_bf16(pa3,PK(3),o[d0],0,0,0);
    #undef PK
  }
}

#ifndef ATTN_STORE16
#define ATTN_STORE16(p,v) (*(u32x4*)(p)=(v))
#endif
template<int THRL> __device__ __forceinline__ void attn_unit(int qb,const bf16*Q,const bf16*__restrict__ K,const bf16*__restrict__ V,bf16*O,char*shm){
  const int tid=threadIdx.x,lane=tid&63,r32=lane&31,hi=lane>>5; const int wid=__builtin_amdgcn_readfirstlane(tid>>6);
  const int q0=qb*QB;
  const bf16*Qw=Q+(long)(q0+wid*QBLK)*DM;
  const bf16*Kh=K,*Vh=V;
  const unsigned lds0=(unsigned)(uintptr_t)shm;
  float*wsf=(float*)(shm+LDS_WS)+wid*64;
  const bf16*ksrc=Kh+(long)lane*DM+wid*8;
  const bf16*vsrc=Vh+(long)(16*(wid&3)+(lane>>2))*DM+(wid>>2)*32+(lane&3)*8;
  const unsigned kdst=lds0+LDS_K+wid*1024, vdst=lds0+LDS_V+wid*1024;
  #define DMA_K(t,slot) glds16(ksrc+(long)(t)*KVBLK*DM,(unsigned)__builtin_amdgcn_readfirstlane(kdst+(slot)))
  #define DMA_V(t,slot) glds16(vsrc+(long)(t)*KVBLK*DM,(unsigned)__builtin_amdgcn_readfirstlane(vdst+(slot)))
  const int vb0=(int)(lds0+LDS_V)+((lane>>4)&1)*32+(lane&3)*8+(4*hi+((lane&15)>>2))*64;
  const char*Kbase=shm+LDS_K; bf16x8 kf[8];
  const lds_cptr shm3=(lds_cptr)shm; const lds_cptr kp0=shm3+LDS_K+hi*1024+r32*16; const lds_cptr vp0=shm3+LDS_V+((lane>>4)&1)*32+(lane&3)*8+(4*hi+((lane&15)>>2))*64;
  const int NT=(q0+QB)/KVBLK;
  DMA_K(0,0);DMA_V(0,0);DMA_K(1,SLOTB);
  bf16x8 qr[4];
  #pragma unroll
  for(int d0=0;d0<4;++d0)qr[d0]=*reinterpret_cast<const bf16x8*>(&Qw[(long)r32*DM+d0*16+hi*8]);
  float mhat=0.f,l_reg=0.f;f32x16 o[2];o[0]=f32x16{};o[1]=f32x16{};f32x16 negm=f32x16{};asm volatile("":"+v"(negm));
  const int qrel=wid*QBLK+r32;
  #define CMASK(P0,P1,t) do{int jb_=(t)-(NT-4); if(jb_>=0)cmask(P0,P1,jb_,qrel,hi);}while(0)
  bool resc=false;
  #define START(P0,P1) do{ const float rm=rowmax(P0,P1); resc=false; \
    { const float dl=rm; mhat=fadd_s(mhat,dl); \
      _Pragma("unroll") for(int r=0;r<16;++r){P0[r]=fsub_s(P0[r],dl);P1[r]=fsub_s(P1[r],dl);} \
      _Pragma("unroll") for(int r=0;r<16;++r)negm[r]=-mhat; asm volatile("":"+v"(negm)); } \
    _Pragma("unroll") for(int r=0;r<16;++r)P0[r]=__builtin_amdgcn_exp2f(P0[r]); }while(0)
  #define RESC() do{ if(resc){ asm volatile("s_waitcnt lgkmcnt(0)":::"memory"); \
      _Pragma("unroll") for(int d_=0;d_<2;++d_) _Pragma("unroll") for(int r=0;r<16;++r)o[d_][r]*=wsf[crow(r,hi)]; } }while(0)
  f32x16 pA0,pA1,pB0,pB1;
  int sl_prev=0,sl_cur=0,sl_next=SLOTB;
  #define ROT() do{sl_prev=sl_cur;sl_cur=sl_next;sl_next=(sl_next==(NSLOT-1)*SLOTB)?0:sl_next+SLOTB;}while(0)
  DMA_K(2,2*SLOTB);
  WAIT_BAR(3);
  qkt(pA0,pA1,Kbase,qr,negm,r32,hi);asm volatile("s_nop 15\n\ts_nop 7":"+v"(pA0),"+v"(pA1));CMASK(pA0,pA1,0);
  START(pA0,pA1);
  _Pragma("unroll") for(int r=0;r<16;++r)pA1[r]=__builtin_amdgcn_exp2f(pA1[r]);
  WAIT_BAR(0);
  DMA_K(3,0);DMA_V(1,SLOTB);
  ROT();
  kload8(kf,kp0+sl_cur);
  WAIT_BAR(2);
  s16x4 vlo[8],vhi[8]; u32x4 pw0,pw1,pw2,pw3;
  #define PKW(P,B) cvtpk_s(P[B],P[B+1])
  #define PAF(k) __builtin_bit_cast(bf16x8,pw##k)
  #define VFR(i) (bf16x8){vlo[i][0],vlo[i][1],vlo[i][2],vlo[i][3],vhi[i][0],vhi[i][1],vhi[i][2],vhi[i][3]}
  #define PIN(x) asm volatile("":"+v"(x))
  #define MX3(a,b,c) __builtin_fmaxf(__builtin_fmaxf((a),(b)),(c))
  #define GAPA(MF,A0,A1,A2,A3,W0,W1,PW) do{ MF; sacc+=A0; sacc+=A1; sacc+=A2; sacc+=A3; PIN(sacc); W0; W1; PIN(PW); SBAR(); }while(0)
  #define EX(v) __builtin_amdgcn_exp2f(v)
  #define GAPB(MF,X,B) do{ MF; X[B]=EX(X[B]); X[B+1]=EX(X[B+1]); X[B+2]=EX(X[B+2]); X[B+3]=EX(X[B+3]); PIN(X); SBAR(); }while(0)
  #define VRD(i) do{ vlo[i]=vtr(vp_+(((i)>>2)*4096+((i)&3)*1024)); vhi[i]=vtr(vp_+(((i)>>2)*4096+((i)&3)*1024+512)); }while(0)
  #define KRD(G,j) do{ if(G){ kload2(kf,kp0+sl_next,j); SBAR(); } }while(0)
  #define STEP(C0,C1,P0,P1,t,GK,GV,GL) do{ SBAR(); \
    const lds_cptr vp_=vp0+sl_prev; \
    VRD(0); SBAR(); float sacc=(P0[0]+P0[1]); \
    GAPA(C0=__builtin_amdgcn_mfma_f32_32x32x16_bf16(kf[0],qr[0],negm,0,0,0), P0[2],P0[3],P0[4],P0[5],     pw0[0]=PKW(P0,0), pw0[1]=PKW(P0,2), pw0); \
    VRD(4); SBAR(); GAPA(C1=__builtin_amdgcn_mfma_f32_32x32x16_bf16(kf[1],qr[0],negm,0,0,0), P0[6],P0[7],P0[8],P0[9],     pw0[2]=PKW(P0,4), pw0[3]=PKW(P0,6), pw0); \
    VRD(1); SBAR(); GAPA(C0=__builtin_amdgcn_mfma_f32_32x32x16_bf16(kf[2],qr[1],C0,0,0,0),   P0[10],P0[11],P0[12],P0[13], pw1[0]=PKW(P0,8), pw1[1]=PKW(P0,10), pw1); \
    VRD(5); SBAR(); GAPA(C1=__builtin_amdgcn_mfma_f32_32x32x16_bf16(kf[3],qr[1],C1,0,0,0),   P0[14],P0[15],P1[0],P1[1],   pw1[2]=PKW(P0,12),pw1[3]=PKW(P0,14), pw1); \
    VRD(2); SBAR(); GAPA(C0=__builtin_amdgcn_mfma_f32_32x32x16_bf16(kf[4],qr[2],C0,0,0,0),   P1[2],P1[3],P1[4],P1[5],     pw2[0]=PKW(P1,0), pw2[1]=PKW(P1,2), pw2); \
    VRD(6); SBAR(); GAPA(C1=__builtin_amdgcn_mfma_f32_32x32x16_bf16(kf[5],qr[2],C1,0,0,0),   P1[6],P1[7],P1[8],P1[9],     pw2[2]=PKW(P1,4), pw2[3]=PKW(P1,6), pw2); \
    VRD(3); SBAR(); GAPA(C0=__builtin_amdgcn_mfma_f32_32x32x16_bf16(kf[6],qr[3],C0,0,0,0),   P1[10],P1[11],P1[12],P1[13], pw3[0]=PKW(P1,8), pw3[1]=PKW(P1,10), pw3); \
    VRD(7); SBAR(); GAPA(C1=__builtin_amdgcn_mfma_f32_32x32x16_bf16(kf[7],qr[3],C1,0,0,0),   P1[14],P1[15],0.f,0.f,       pw3[2]=PKW(P1,12),pw3[3]=PKW(P1,14), pw3); \
    l_reg+=sacc; \
    if(GK){DMA_K((t)+3,sl_cur);} if(GV){DMA_V((t)+1,sl_next);} \
    CMASK(C0,C1,t); \
    { float a=MX3(C0[0],C0[1],C1[0]),b=MX3(C0[2],C0[3],C1[1]); a=MX3(a,C1[2],C1[3]); \
      _Pragma("unroll") for(int r=4;r<16;r+=4){a=MX3(a,C0[r],C0[r+1]);b=MX3(b,C0[r+2],C0[r+3]);a=MX3(a,C1[r],C1[r+1]);b=MX3(b,C1[r+2],C1[r+3]);} \
      float rm=__builtin_fmaxf(a,b); { auto rr=__builtin_amdgcn_permlane32_swap(__float_as_uint(rm),__float_as_uint(rm),false,false); rm=__builtin_fmaxf(__uint_as_float(rr[0]),__uint_as_float(rr[1])); } \
      resc=false; \
      if(__builtin_expect(__any(rm>(float)THRL),0)){ const float dl=__builtin_fmaxf(rm,0.f); mhat+=dl; \
        _Pragma("unroll") for(int r=0;r<16;++r){C0[r]-=dl;C1[r]-=dl;} \
        _Pragma("unroll") for(int r=0;r<16;++r)negm[r]=-mhat; asm volatile("":"+v"(negm)); \
        const float f=__builtin_amdgcn_exp2f(-dl); l_reg*=f; if(hi==0)wsf[r32]=f; resc=true; } } \
    SBAR(); \
    GAPB(o[0]=__builtin_amdgcn_mfma_f32_32x32x16_bf16(PAF(0),VFR(0),o[0],0,0,0), C0,0); \
    GAPB(o[1]=__builtin_amdgcn_mfma_f32_32x32x16_bf16(PAF(0),VFR(4),o[1],0,0,0), C0,4); \
    KRD(GL,0); GAPB(o[0]=__builtin_amdgcn_mfma_f32_32x32x16_bf16(PAF(1),VFR(1),o[0],0,0,0), C0,8); \
    KRD(GL,1); GAPB(o[1]=__builtin_amdgcn_mfma_f32_32x32x16_bf16(PAF(1),VFR(5),o[1],0,0,0), C0,12); \
    KRD(GL,2); GAPB(o[0]=__builtin_amdgcn_mfma_f32_32x32x16_bf16(PAF(2),VFR(2),o[0],0,0,0), C1,0); \
    KRD(GL,3); GAPB(o[1]=__builtin_amdgcn_mfma_f32_32x32x16_bf16(PAF(2),VFR(6),o[1],0,0,0), C1,4); \
    GAPB(o[0]=__builtin_amdgcn_mfma_f32_32x32x16_bf16(PAF(3),VFR(3),o[0],0,0,0), C1,8); \
    GAPB(o[1]=__builtin_amdgcn_mfma_f32_32x32x16_bf16(PAF(3),VFR(7),o[1],0,0,0), C1,12); \
    }while(0)
  int t=1;
  #undef CMASK
  #define CMASK(P0,P1,t) do{}while(0)
  for(;t+5<NT;t+=2){
    STEP(pB0,pB1,pA0,pA1,t,true,true,true);     WAIT_BAR(2); RESC(); ROT();
    STEP(pA0,pA1,pB0,pB1,t+1,true,true,true);   WAIT_BAR(2); RESC(); ROT();
  }
  #undef CMASK
  #define CMASK(P0,P1,t) do{int jb_=(t)-(NT-4); if(jb_>=0)cmask(P0,P1,jb_,qrel,hi);}while(0)
  #define ENDW(tt) do{ if((tt)+3<NT){WAIT_BAR(2);} else if((tt)+2<NT){WAIT_BAR(1);} else {WAIT_BAR(0);} }while(0)
  for(;t+1<NT;t+=2){
    STEP(pB0,pB1,pA0,pA1,t,(t+3<NT),(t+1<NT),(t+1<NT));       ENDW(t);   RESC(); ROT();
    STEP(pA0,pA1,pB0,pB1,t+1,(t+4<NT),(t+2<NT),(t+2<NT));     ENDW(t+1); RESC(); ROT();
  }
  STEP(pB0,pB1,pA0,pA1,NT-1,false,false,false); RESC();
  { float sacc=pB0[0]+pB0[1]; _Pragma("unroll") for(int r=2;r<16;++r)sacc+=pB0[r]; _Pragma("unroll") for(int r=0;r<16;++r)sacc+=pB1[r]; l_reg+=sacc;
    pw0=(u32x4){PKW(pB0,0),PKW(pB0,2),PKW(pB0,4),PKW(pB0,6)};pw1=(u32x4){PKW(pB0,8),PKW(pB0,10),PKW(pB0,12),PKW(pB0,14)};pw2=(u32x4){PKW(pB1,0),PKW(pB1,2),PKW(pB1,4),PKW(pB1,6)};pw3=(u32x4){PKW(pB1,8),PKW(pB1,10),PKW(pB1,12),PKW(pB1,14)};
    SBAR(); pv(o,vb0+sl_cur,PAF(0),PAF(1),PAF(2),PAF(3)); }
  #undef PKW
  #undef PAF
  #undef VFR
  #undef PIN
  #undef MX3
  #undef GAPA
  #undef GAPB
  #undef EX
  #undef VRD
  #undef KRD
  #undef STEP
  #undef ENDW
  {auto rr=__builtin_amdgcn_permlane32_swap(__float_as_uint(l_reg),__float_as_uint(l_reg),false,false);l_reg=__uint_as_float(rr[0])+__uint_as_float(rr[1]);}
  if(hi==0)wsf[32+r32]=l_reg;asm volatile("s_waitcnt lgkmcnt(0)":::"memory");
  float rli[16];
  #pragma unroll
  for(int r=0;r<16;++r)rli[r]=__builtin_amdgcn_rcpf(wsf[32+crow(r,hi)]);
  bf16*Ow=O+(long)(q0+wid*QBLK)*ODM;
  { bf16*stg=(bf16*)(shm+LDS_OST)+wid*2048;
    #pragma unroll
    for(int r=0;r<16;++r){const int orow=crow(r,hi);
      #pragma unroll
      for(int d0=0;d0<2;++d0)stg[orow*64+d0*32+r32]=__float2bfloat16(o[d0][r]*rli[r]);}
    asm volatile("s_waitcnt lgkmcnt(0)":::"memory");
    #pragma unroll
    for(int i=0;i<4;++i){const int row=i*8+(lane>>3),ch=lane&7; const u32x4 v=*(const u32x4*)(stg+row*64+ch*8); ATTN_STORE16(Ow+(long)row*ODM+ch*8,v);} }
  asm volatile("s_waitcnt lgkmcnt(0)\n\ts_barrier":::"memory");
  #undef DMA_K
  #undef DMA_V
  #undef CMASK
  #undef START
  #undef RESC
  #undef ROT
}
constexpr int ATTN_LDS_BYTES=LDS_BYTES;
struct AttnTensors { const bf16* Q; const bf16* K; const bf16* V; bf16* O; };
template<int THRL=8> __device__ __forceinline__ void attn_phase(char*lds,const AttnTensors&T,int vcu,int G){
  for(int i=0;;++i){
    int combo,qb;
    if(G==256){ if(i>=8)break; combo=vcu>>1; const int qlo=2*(i>>1)+(vcu&1); qb=(i&1)?15-qlo:qlo; }
    else { const int idx=i*G+vcu; if(idx>=2048)break; combo=idx&127; qb=15-(idx>>7); }
    const int b=combo>>5, hc=(combo>>1)&15, vh=combo&1;
    const long r0=(long)b*SEQ;
    attn_unit<THRL>(qb, T.Q+r0*DM+hc*64, T.K+r0*DM+hc*64, T.V+r0*DM+(hc>>1)*128+vh*64, T.O+r0*ODM+hc*128+vh*64, lds);
  }
}
#undef SBAR
#undef WAIT_BAR
}

#define GAS __attribute__((address_space(1)))
#define LAS __attribute__((address_space(3)))
typedef unsigned short bf16;
typedef unsigned v4u __attribute__((ext_vector_type(4)));
typedef float f32x4 __attribute__((ext_vector_type(4)));
typedef short bf16x8 __attribute__((ext_vector_type(8)));
typedef GAS unsigned gu32;
typedef GAS unsigned long long gu64;
#define RLX_AGENT __ATOMIC_RELAXED, __HIP_MEMORY_SCOPE_AGENT
#define LDS_WAIT() asm volatile("s_waitcnt lgkmcnt(0)" ::: "memory")
#define VM_WAIT() asm volatile("s_waitcnt vmcnt(0)" ::: "memory")
__device__ __forceinline__ unsigned long long rt() { return __builtin_amdgcn_s_memrealtime(); }
__device__ __forceinline__ unsigned f2bf(float f) { unsigned u = __builtin_bit_cast(unsigned, f); return (u + 0x7fffu + ((u >> 16) & 1u)) >> 16; }
__device__ __forceinline__ unsigned pk2(float lo, float hi) { return f2bf(lo) | (f2bf(hi) << 16); }

#define XB_TMO      128
#define XB_XCNT(j)  (256  + 64 * (j))
#define XB_XSUB(j)  (1280 + 64 * (j))
#define XB_XGEN(j)  (2304 + 64 * (j))
#define XB_TOP      3328
#define XB_TOPGEN   3392
#define XCD_BAR_WORDS 3456
#define XB_SPIN_CAP (1u << 18)

__device__ __forceinline__ unsigned xb_ld(unsigned* p)              { return __hip_atomic_load(p, __ATOMIC_RELAXED, __HIP_MEMORY_SCOPE_AGENT); }
__device__ __forceinline__ unsigned xb_add(unsigned* p, unsigned v) { return __hip_atomic_fetch_add(p, v, __ATOMIC_RELAXED, __HIP_MEMORY_SCOPE_AGENT); }
__device__ __forceinline__ unsigned xb_xcc_id() { return (unsigned)__builtin_amdgcn_s_getreg((3 << 11) | 20) & 0xFu; }
#define XB_SPIN(cond, bar) do { unsigned _sp = 0; while (cond) { __builtin_amdgcn_s_sleep(1); \
    if ((++_sp & 255u) == 0u) { if (xb_ld(&(bar)[XB_TMO])) break; if (_sp > XB_SPIN_CAP) { atomicAdd(&(bar)[XB_TMO], 1u); break; } } } } while (0)

struct XcdBarrier {
    unsigned* bar; unsigned x;
    volatile LAS unsigned* st;
};

__device__ __forceinline__ XcdBarrier xcd_barrier_post(unsigned* bar, volatile LAS unsigned* st) {
    XcdBarrier b; b.bar = bar; b.x = xb_xcc_id(); b.st = st;
    if (threadIdx.x == 0) (void)xb_add(&bar[XB_XCNT(b.x)], 1u);
    return b;
}
__device__ __forceinline__ void xcd_barrier_complete(unsigned* bar, unsigned x, unsigned& nloc, unsigned& nx) {
    const unsigned G = gridDim.x * gridDim.y * gridDim.z;
    unsigned sum, cnt, mine, sp = 0u;
    for (;;) {
        sum = 0u; cnt = 0u; mine = 0u;
#pragma unroll
        for (unsigned j = 0; j < 16; ++j) { const unsigned c = xb_ld(&bar[XB_XCNT(j)]); sum += c; cnt += (c > 0u) ? 1u : 0u; mine = (j == x) ? c : mine; }
        if (sum == G) break;
        __builtin_amdgcn_s_sleep(1);
        if ((++sp & 255u) == 0u) { if (xb_ld(&bar[XB_TMO])) break; if (sp > XB_SPIN_CAP) { atomicAdd(&bar[XB_TMO], 1u); break; } }
    }
    nloc = mine > 0u ? mine : 1u; nx = cnt > 0u ? cnt : 1u;
}

__device__ __forceinline__ void xcd_barrier(const XcdBarrier& b) {
    asm volatile("s_waitcnt vmcnt(0)" ::: "memory");
    __syncthreads();
    if (threadIdx.x == 0) {
        unsigned* bar = b.bar;
        __builtin_amdgcn_s_waitcnt(0);
        unsigned nloc = b.st[0], nx = b.st[1];
        if (nloc == 0u) { xcd_barrier_complete(bar, b.x, nloc, nx); b.st[0] = nloc; b.st[1] = nx; }
        const unsigned old = xb_add(&bar[XB_XSUB(b.x)], 1u);
        const unsigned gen = old / nloc;
        if (old + 1u == (gen + 1u) * nloc) {
            __builtin_amdgcn_fence(__ATOMIC_RELEASE, "agent");
            asm volatile("s_waitcnt vmcnt(0)" ::: "memory");
            const unsigned og = xb_add(&bar[XB_TOP], 1u);
            const unsigned tg = og / nx;
            if (og + 1u == (tg + 1u) * nx) xb_add(&bar[XB_TOPGEN], 1u);
            else XB_SPIN(xb_ld(&bar[XB_TOPGEN]) == tg, bar);
            __builtin_amdgcn_fence(__ATOMIC_ACQUIRE, "agent");
            xb_add(&bar[XB_XGEN(b.x)], 1u);
            asm volatile("s_waitcnt vmcnt(0)" ::: "memory");
        } else {
            XB_SPIN(xb_ld(&bar[XB_XGEN(b.x)]) == gen, bar);
            __builtin_amdgcn_fence(__ATOMIC_ACQUIRE, "agent");
            asm volatile("s_waitcnt vmcnt(0)" ::: "memory");
        }
    }
    __syncthreads();
}

constexpr int NWAVES = 8;
constexpr int T_ = 16384, SEQL = 4096, DMODEL = 2048, NINP = 10752, NIN_SRC = 10688;
constexpr int RWW = 3584;
constexpr int NEXP = 32, DEXP = 1024, MAXROWS = 40960, MAXTILES = 160;
constexpr size_t MiB = 1u << 20;
constexpr size_t WS_CTL = 0, CTL_ZERO_BYTES = 1 * MiB;
constexpr size_t WS_ROPE = 1 * MiB;
constexpr size_t WS_BON = 2 * MiB;
constexpr size_t WS_ASG_E = 3 * MiB, WS_ASG_POS = WS_ASG_E + 256 * 1024, WS_ASG_GATE = WS_ASG_POS + 256 * 1024, WS_TOKDEST = WS_ASG_GATE + 256 * 1024;
constexpr size_t WS_ROWGATE = 4 * MiB;
constexpr size_t WS_WIN = 16 * MiB;
constexpr size_t WS_WPA = 58 * MiB, WS_WPB = 62 * MiB, WS_WOUT = 66 * MiB;
constexpr size_t WS_WLORA = 74 * MiB;
constexpr size_t WS_WRT = 76 * MiB;
constexpr size_t WS_H = 80 * MiB;
constexpr size_t WS_Q = 144 * MiB, WS_K = 176 * MiB, WS_V = 208 * MiB, WS_G = 240 * MiB, WS_RW = 368 * MiB;
constexpr size_t WS_RS = 480 * MiB, WS_KS = 512 * MiB, WS_VS = 544 * MiB, WS_LA = 576 * MiB, WS_LD = 600 * MiB, WS_AS = 664 * MiB, WS_GG = 696 * MiB, WS_Y = 728 * MiB;
constexpr size_t WS_O = 368 * MiB;
constexpr size_t WS_YA = 144 * MiB, WS_YB = 176 * MiB;
constexpr size_t WS_TMP = 480 * MiB;
constexpr size_t WS_MERGED = 600 * MiB;
constexpr size_t WS_WGU = 144 * MiB, WS_WD = 400 * MiB;
constexpr size_t WS_LOGIT = 528 * MiB;
constexpr size_t WS_XG = 544 * MiB, WS_ACT = 704 * MiB, WS_YD = 784 * MiB, WS_END = 944 * MiB;
constexpr int CW_CNT = 64;
constexpr int CW_BAR = 4096;
constexpr int RING_OFF = 0, RING_BYTES = 131072;
constexpr int LDSCTL_OFF = RING_BYTES, MISC_OFF = LDSCTL_OFF + 320;
constexpr int TT_OFF = LDSCTL_OFF + 1024;
constexpr int LDS_BYTES = 147456;

typedef unsigned short bfu;
typedef unsigned u32x2 __attribute__((ext_vector_type(2)));
typedef float f32x2 __attribute__((ext_vector_type(2)));

__device__ __forceinline__ float wave_sum(float v) {
#pragma unroll
    for (int o = 1; o < 64; o <<= 1) v += __shfl_xor(v, o);
    return v;
}
__device__ __forceinline__ float bfl(unsigned w) { return __uint_as_float(w << 16); }
__device__ __forceinline__ float bfh(unsigned w) { return __uint_as_float(w & 0xffff0000u); }
__device__ __forceinline__ float sigm(float x) { return 1.0f / (1.0f + __expf(-x)); }
__device__ __forceinline__ void unpack16(const v4u a, const v4u b, float (&x)[16]) {
    x[0] = bfl(a.x); x[1] = bfh(a.x); x[2] = bfl(a.y); x[3] = bfh(a.y); x[4] = bfl(a.z); x[5] = bfh(a.z); x[6] = bfl(a.w); x[7] = bfh(a.w);
    x[8] = bfl(b.x); x[9] = bfh(b.x); x[10] = bfl(b.y); x[11] = bfh(b.y); x[12] = bfl(b.z); x[13] = bfh(b.z); x[14] = bfl(b.w); x[15] = bfh(b.w);
}
__device__ __forceinline__ void pack16(const float (&x)[16], v4u& a, v4u& b) {
    a.x = pk2(x[0], x[1]); a.y = pk2(x[2], x[3]); a.z = pk2(x[4], x[5]); a.w = pk2(x[6], x[7]);
    b.x = pk2(x[8], x[9]); b.y = pk2(x[10], x[11]); b.z = pk2(x[12], x[13]); b.w = pk2(x[14], x[15]);
}
__device__ __forceinline__ float dpp_f(float v, int ctrl_sel) {
    const int x = __builtin_bit_cast(int, v); int r;
    if (ctrl_sel == 0) r = __builtin_amdgcn_update_dpp(0, x, 0xB1, 0xF, 0xF, true);
    else if (ctrl_sel == 1) r = __builtin_amdgcn_update_dpp(0, x, 0x4E, 0xF, 0xF, true);
    else if (ctrl_sel == 2) r = __builtin_amdgcn_update_dpp(0, x, 0x141, 0xF, 0xF, true);
    else r = __builtin_amdgcn_update_dpp(0, x, 0x140, 0xF, 0xF, true);
    return __builtin_bit_cast(float, r);
}
__device__ __forceinline__ float row16_sum(float v) { v += dpp_f(v, 0); v += dpp_f(v, 1); v += dpp_f(v, 2); v += dpp_f(v, 3); return v; }
__device__ __forceinline__ float oct_sum(float v) { v += dpp_f(v, 0); v += dpp_f(v, 1); v += dpp_f(v, 2); return v; }
__device__ __forceinline__ float quad_sum(float v) { v += dpp_f(v, 0); v += dpp_f(v, 1); return v; }

__device__ __forceinline__ void transpose_item(const float* W, int ldw, int k0, int n0, bfu* WT, int ldk, size_t drow0, LAS float* scr, int lane) {
#pragma unroll 8
    for (int i = 0; i < 32; ++i) { const int kk = 2 * i + (lane >> 5); scr[kk * 33 + (lane & 31)] = W[(size_t)(k0 + kk) * ldw + n0 + (lane & 31)]; }
    LDS_WAIT(); asm volatile("" ::: "memory");
    const int c = lane & 7;
#pragma unroll
    for (int j = 0; j < 4; ++j) { const int n = (lane >> 3) + 8 * j; const LAS float* s = scr + (8 * c) * 33 + n;
        v4u o; o.x = pk2(s[0 * 33], s[1 * 33]); o.y = pk2(s[2 * 33], s[3 * 33]); o.z = pk2(s[4 * 33], s[5 * 33]); o.w = pk2(s[6 * 33], s[7 * 33]);
        *(GAS v4u*)(WT + (drow0 + n) * ldk + k0 + 8 * c) = o; }
    LDS_WAIT(); asm volatile("" ::: "memory");
}
__device__ __forceinline__ void rms_row_to_bf16(const float* xrow, const float* g, bfu* orow, int lane, float eps) {
    const GAS f32x4* xr = (const GAS f32x4*)xrow + lane; const GAS f32x4* gr = (const GAS f32x4*)g + lane;
    f32x4 v[8]; float s = 0.f;
#pragma unroll
    for (int j = 0; j < 8; ++j) { v[j] = xr[64 * j]; s += (v[j].x * v[j].x + v[j].y * v[j].y) + (v[j].z * v[j].z + v[j].w * v[j].w); }
    const float rstd = 1.0f / sqrtf(wave_sum(s) * (1.f / 2048.f) + eps);
    GAS unsigned long long* o8 = (GAS unsigned long long*)orow + lane;
#pragma unroll
    for (int j = 0; j < 8; ++j) { const f32x4 gg = gr[64 * j]; o8[64 * j] = (unsigned long long)pk2(v[j].x * rstd * gg.x, v[j].y * rstd * gg.y) | ((unsigned long long)pk2(v[j].z * rstd * gg.z, v[j].w * rstd * gg.w) << 32); }
}


typedef const __attribute__((address_space(4))) unsigned char* kaptr_t;
#define PH_BEGIN() kaptr_t ka_ = (kaptr_t)__builtin_amdgcn_kernarg_segment_ptr(); asm volatile("" : "+s"(ka_)); unsigned char* const ws = *(unsigned char* const __attribute__((address_space(4)))*)(ka_ + 264); (void)ws; int lane = (int)threadIdx.x; asm volatile("" : "+v"(lane)); lane &= 63
#define INP(k) (*(const float* const __attribute__((address_space(4)))*)(ka_ + 8 * (k)))
#define OUTP (*(float* const __attribute__((address_space(4)))*)(ka_ + 256))
#define ctl ((gu32*)(ws + WS_CTL))
#define Hb ((bfu*)(ws + WS_H))
#define Qb ((bfu*)(ws + WS_Q))
#define Kb ((bfu*)(ws + WS_K))
#define Vb ((bfu*)(ws + WS_V))
#define Gb ((bfu*)(ws + WS_G))
#define RWb ((bfu*)(ws + WS_RW))
#define RSb ((bfu*)(ws + WS_RS))
#define KSb ((bfu*)(ws + WS_KS))
#define VSb ((bfu*)(ws + WS_VS))
#define LAb ((bfu*)(ws + WS_LA))
#define LDf ((float*)(ws + WS_LD))
#define ASb ((bfu*)(ws + WS_AS))
#define GGb ((bfu*)(ws + WS_GG))
#define Yf ((float*)(ws + WS_Y))
#define Ob ((bfu*)(ws + WS_O))
#define YAb ((bfu*)(ws + WS_YA))
#define YBb ((bfu*)(ws + WS_YB))
#define TMPb ((bfu*)(ws + WS_TMP))
#define MRGb ((bfu*)(ws + WS_MERGED))
#define WINt ((bfu*)(ws + WS_WIN))
#define WPAt ((bfu*)(ws + WS_WPA))
#define WPBt ((bfu*)(ws + WS_WPB))
#define WOUTt ((bfu*)(ws + WS_WOUT))
#define WLORAt ((bfu*)(ws + WS_WLORA))
#define WRTt ((bfu*)(ws + WS_WRT))
#define WGUt ((bfu*)(ws + WS_WGU))
#define WDt ((bfu*)(ws + WS_WD))
#define ROPE ((float*)(ws + WS_ROPE))
#define BON ((float*)(ws + WS_BON))
#define ASG_E ((int*)(ws + WS_ASG_E))
#define ASG_POS ((int*)(ws + WS_ASG_POS))
#define ASG_GATE ((float*)(ws + WS_ASG_GATE))
#define TOKDEST ((int*)(ws + WS_TOKDEST))
#define ROWGATE ((float*)(ws + WS_ROWGATE))
#define LOGIT ((float*)(ws + WS_LOGIT))
#define XGb ((bfu*)(ws + WS_XG))
#define ACTb ((bfu*)(ws + WS_ACT))
#define YDb ((bfu*)(ws + WS_YD))
static_assert(sizeof(void*) == 8, "kernarg offsets");

#ifndef DBG_BONV
#define DBG_BONV bs
#endif
struct Args { const float* in[32]; float* out; unsigned char* ws; int ph_lo, ph_hi; };

__global__ void __launch_bounds__(NWAVES * 64, 2) mk_fwd(Args args) {
    extern __shared__ __attribute__((aligned(16))) unsigned char lds[];
    LAS unsigned char* L = (LAS unsigned char*)lds;
    volatile LAS unsigned* MISC = (volatile LAS unsigned*)(L + MISC_OFF);
    const int tid = threadIdx.x, wave = __builtin_amdgcn_readfirstlane(tid >> 6);
    const int G = gridDim.x; const int bx = blockIdx.x; const int vcu = (G % 8 == 0) ? (bx % 8) * (G / 8) + bx / 8 : bx;
    const int gw = vcu * NWAVES + wave, NGW = G * NWAVES;
    for (int u = tid; u < (LDS_BYTES - LDSCTL_OFF) / 4; u += NWAVES * 64) ((LAS unsigned*)(L + LDSCTL_OFF))[u] = 0u;
    __syncthreads();
    XcdBarrier bar; { unsigned char* const ws = args.ws; bar.bar = (unsigned*)(ctl + CW_BAR); bar.x = 0; bar.st = nullptr;
    if (!MK_SPLIT) bar = xcd_barrier_post((unsigned*)(ctl + CW_BAR), MISC + 8); }
    const int lo = args.ph_lo, hi = args.ph_hi;
#ifdef PH_ONLY
#define IN(k) ((k) == PH_ONLY && lo <= (k) && (k) < hi)
#else
#define IN(k) (lo <= (k) && (k) < hi)
#endif
#define SEAM() do { if (!MK_SPLIT) xcd_barrier(bar); } while (0)

    if (IN(0)) { PH_BEGIN();
        LAS float* scr = (LAS float*)(L + RING_OFF + wave * 16384);
        {
            const float* W = INP(2); constexpr int NB = NIN_SRC / 32, NIT = 32 * NB;
            for (int it = gw; it < NIT; it += NGW) { const int kb = it / NB, nb = it % NB, n0 = 32 * nb; transpose_item(W, NIN_SRC, 64 * kb, n0, WINt, 2048, (size_t)(n0 + (n0 >= 6592 ? 64 : 0)), scr, lane); }
            for (int i = gw * 64 + lane; i < 64 * 2048 / 8; i += NGW * 64) *(GAS v4u*)(WINt + (size_t)6592 * 2048 + (size_t)i * 8) = (v4u){0u, 0u, 0u, 0u};
        }
        { const float* W = INP(21); for (int it = gw; it < 16 * 64; it += NGW) { const int kb = it / 64, nb = it % 64; transpose_item(W, 2048, 64 * kb, 32 * nb, WPAt, 1024, (size_t)(32 * nb), scr, lane); } }
        { const float* W = INP(22); for (int it = gw; it < 16 * 64; it += NGW) { const int kb = it / 64, nb = it % 64; transpose_item(W, 2048, 64 * kb, 32 * nb, WPBt, 1024, (size_t)(32 * nb), scr, lane); } }
        { const float* W = INP(23); for (int it = gw; it < 32 * 64; it += NGW) { const int kb = it / 64, nb = it % 64; transpose_item(W, 2048, 64 * kb, 32 * nb, WOUTt, 2048, (size_t)(32 * nb), scr, lane); } }
        {
            const float* wu = INP(12); const float* au = INP(14); const float* gu = INP(15);
            for (int it = gw * 64 + lane; it < 3 * 32 * 1024; it += NGW * 64) { const int n = it & 1023, kg = (it >> 10) & 31, which = it >> 15; const float* src = which == 0 ? wu : (which == 1 ? au : gu); const int kmax = which == 2 ? 256 : 96;
                float v[8];
#pragma unroll
                for (int j = 0; j < 8; ++j) { const int k = kg * 8 + j; v[j] = k < kmax ? src[(size_t)k * 1024 + n] : 0.f; }
                v4u o; o.x = pk2(v[0], v[1]); o.y = pk2(v[2], v[3]); o.z = pk2(v[4], v[5]); o.w = pk2(v[6], v[7]);
                *(GAS v4u*)(WLORAt + ((size_t)(which * 1024 + n) * 256 + kg * 8)) = o; }
        }
        {
            const float* rg = INP(25); const float* re = INP(27);
            for (int it = gw * 64 + lane; it < 256 * 256; it += NGW * 64) { const int n = it & 255, kg = it >> 8; float v[8];
#pragma unroll
                for (int j = 0; j < 8; ++j) { const int k = kg * 8 + j; v[j] = n < 4 ? rg[k * 4 + n] : (n < 36 ? re[k * 32 + (n - 4)] : 0.f); }
                v4u o; o.x = pk2(v[0], v[1]); o.y = pk2(v[2], v[3]); o.z = pk2(v[4], v[5]); o.w = pk2(v[6], v[7]);
                *(GAS v4u*)(WRTt + ((size_t)n * 2048 + kg * 8)) = o; }
        }
#ifdef DBG_ZERO_AS
        for (size_t i = (size_t)gw * 64 + lane; i < (size_t)T_ * 1024 / 8; i += (size_t)NGW * 64) *(GAS v4u*)(ASb + i * 8) = (v4u){0u, 0u, 0u, 0u};
#endif
        for (int it = gw * 64 + lane; it < 4096 * 8; it += NGW * 64) { const int pos = it >> 3, i = it & 7; const float inv = exp2f(-(float)i * 0.125f * 18.931568569324174f);
            const float ang = (float)pos * inv; const float n = rintf(ang * 0.15915494309189535f); float r = fmaf(-n, 6.28125f, ang); r = fmaf(-n, 0.0019353071795864769f, r);
            ROPE[it] = __cosf(r); ROPE[4096 * 8 + it] = __sinf(r); }
        for (int m = gw; m < T_; m += NGW) rms_row_to_bf16(INP(0) + (size_t)m * 2048, INP(1), Hb + (size_t)m * 2048, lane, 1e-6f);
        SEAM();
    }

    if (IN(1)) { PH_BEGIN();
        pg8::Gemm g{Hb, WINt, 2048, 2048}; pg8::StaticOrder S; S.init(T_, NINP, G, bx);
        pg8::EpiWin E{Qb, Kb, Vb, RWb, Gb};
        pg8::gemm_phase<pg8::EpiWin, pg8::StaticOrder, true, true>(L + RING_OFF, g, S, E);
        SEAM();
    }

    if (IN(2)) { PH_BEGIN();
        const float* qg = INP(3); const float* kg = INP(4); const float* mu = INP(10);
        const int quarter = lane & 3;
        float gq[16], gk[16], mur[16], muk[16], muv[16], mul[7];
#pragma unroll
        for (int i = 0; i < 16; ++i) { gq[i] = qg[16 * quarter + i]; gk[i] = kg[16 * quarter + i]; mur[i] = mu[16 * lane + i]; muk[i] = mu[1024 + 16 * lane + i]; muv[i] = mu[2048 + 16 * lane + i]; }
#pragma unroll
        for (int i = 0; i < 7; ++i) mul[i] = mu[3072 + lane + 64 * i];
        const float QSC = 0.125f * 1.4426950408889634f;
        for (int m = gw; m < T_; m += NGW) {
            const int pos = m & (SEQL - 1);
            float cs[8], sn[8];
            if (quarter == 0) {
#pragma unroll
                for (int i = 0; i < 8; ++i) { cs[i] = ROPE[pos * 8 + i]; sn[i] = ROPE[4096 * 8 + pos * 8 + i]; }
            }
#pragma unroll
            for (int qk = 0; qk < 2; ++qk) {
                bfu* p = (qk == 0 ? Qb : Kb) + (size_t)m * 1024 + 16 * lane;
                const v4u a = *(const GAS v4u*)p, b = *(const GAS v4u*)(p + 8);
                float xv[16]; unpack16(a, b, xv);
                float ss = 0.f;
#pragma unroll
                for (int i = 0; i < 16; ++i) ss += xv[i] * xv[i];
                ss = quad_sum(ss);
                const float rstd = 1.0f / sqrtf(ss * (1.f / 64.f) + 1e-6f);
#pragma unroll
                for (int i = 0; i < 16; ++i) xv[i] = xv[i] * rstd * (qk == 0 ? gq[i] : gk[i]);
                if (quarter == 0) {
#pragma unroll
                    for (int i = 0; i < 8; ++i) { const float x1 = xv[i], x2 = xv[8 + i]; xv[i] = x1 * cs[i] - x2 * sn[i]; xv[8 + i] = x2 * cs[i] + x1 * sn[i]; }
                }
                if (qk == 0) {
#pragma unroll
                    for (int i = 0; i < 16; ++i) xv[i] *= QSC;
                }
                v4u oa, ob; pack16(xv, oa, ob);
                *(GAS v4u*)p = oa; *(GAS v4u*)(p + 8) = ob;
            }
            const bool has_prev = pos != 0;
            const bfu* cur = RWb + (size_t)m * RWW; const bfu* prv = cur - RWW;
#pragma unroll
            for (int seg = 0; seg < 3; ++seg) {
                const bfu* pc = cur + seg * 1024 + 16 * lane; const bfu* pp = prv + seg * 1024 + 16 * lane;
                const v4u a = *(const GAS v4u*)pc, b = *(const GAS v4u*)(pc + 8);
                v4u c = (v4u){0u, 0u, 0u, 0u}, d = c;
                if (has_prev) { c = *(const GAS v4u*)pp; d = *(const GAS v4u*)(pp + 8); }
                float xc[16], xp[16]; unpack16(a, b, xc); unpack16(c, d, xp);
#pragma unroll
                for (int i = 0; i < 16; ++i) { const float mm = seg == 0 ? mur[i] : (seg == 1 ? muk[i] : muv[i]); xc[i] = xc[i] + (xp[i] - xc[i]) * mm; }
                v4u oa, ob; pack16(xc, oa, ob);
                bfu* po = (seg == 0 ? RSb : (seg == 1 ? KSb : VSb)) + (size_t)m * 1024 + 16 * lane;
                *(GAS v4u*)po = oa; *(GAS v4u*)(po + 8) = ob;
            }
            bfu* law = LAb + (size_t)m * 256; bfu* laa = LAb + (size_t)(T_ + m) * 256; bfu* lag = LAb + (size_t)(2 * T_ + m) * 256;
#pragma unroll
            for (int i = 0; i < 7; ++i) {
                const int c = lane + 64 * i;
                const float xc = bfl((unsigned)cur[3072 + c]); const float xp = has_prev ? bfl((unsigned)prv[3072 + c]) : 0.f;
                const float z = xc + (xp - xc) * mul[i];
                if (c < 96) { const float e2 = __expf(2.f * z); law[c] = (bfu)f2bf(1.0f - 2.0f / (e2 + 1.0f)); }
                else if (c < 192) laa[c - 96] = (bfu)f2bf(z);
                else lag[c - 192] = (bfu)f2bf(sigm(z));
            }
            for (int c = 96 + lane; c < 256; c += 64) { law[c] = 0; laa[c] = 0; }
        }
        SEAM();
    }

    if (IN(3)) { PH_BEGIN();
        const attn_body::AttnTensors AT{(const attn_body::bf16*)Qb, (const attn_body::bf16*)Kb, (const attn_body::bf16*)Vb, (attn_body::bf16*)Ob};
        attn_body::attn_phase<8>((char*)lds + RING_OFF, AT, vcu, G);
    }

    if (IN(3)) { PH_BEGIN();
        pg8::Gemm g{LAb, WLORAt, 256, 256}; pg8::LoraOrder S; S.so.init(3 * T_, 1024, G, bx);
        pg8::EpiLora E{LDf, ASb, GGb, INP(11), INP(13)};
        pg8::gemm_phase<pg8::EpiLora, pg8::LoraOrder, true, true>(L + RING_OFF, g, S, E);
        SEAM();
    }
    if (IN(4)) { PH_BEGIN();
        constexpr int TC = 32, NCH = SEQL / TC;
        constexpr int BUF_F = 5 * TC * 64 + TC * 16;
        LAS float* SB = (LAS float*)(L + RING_OFF);
        LAS float* YS = SB + 2 * BUF_F;
        const float* k_k = INP(16); const float* k_a = INP(17); const float* r_k = INP(18);
        for (int unit = vcu; unit < 256; unit += G) {
            const int bh = unit >> 2, rq = unit & 3, b = bh >> 4, h = bh & 15;
            const size_t row0 = (size_t)b * SEQL;
            if (wave >= 4) {
                const int t2 = tid - 256, tk = t2 >> 3, part = t2 & 7, col = h * 64 + 8 * part;
                float kkc[8], kac[8], rkc[8];
#pragma unroll
                for (int i = 0; i < 8; ++i) { kkc[i] = k_k[col + i]; kac[i] = k_a[col + i]; rkc[i] = r_k[col + i]; }
                v4u rk8, ra8, rr8, rv8 = (v4u){0u, 0u, 0u, 0u}; f32x4 rl0, rl1;
#define SCAN_LOAD(c) do { const size_t mrow = row0 + (size_t)(c) * TC + tk; rk8 = *(const GAS v4u*)(KSb + mrow * 1024 + col); ra8 = *(const GAS v4u*)(ASb + mrow * 1024 + col); rr8 = *(const GAS v4u*)(RSb + mrow * 1024 + col); \
        rl0 = *(const GAS f32x4*)(LDf + mrow * 1024 + col); rl1 = *(const GAS f32x4*)(LDf + mrow * 1024 + col + 4); if (part < 2) rv8 = *(const GAS v4u*)(VSb + mrow * 1024 + h * 64 + 16 * rq + 8 * part); } while (0)
#define SCAN_STAGE(c) do { LAS float* B_ = SB + ((c) & 1) * BUF_F; float kv[8], av[8], rv[8], lv[8]; \
        kv[0] = bfl(rk8.x); kv[1] = bfh(rk8.x); kv[2] = bfl(rk8.y); kv[3] = bfh(rk8.y); kv[4] = bfl(rk8.z); kv[5] = bfh(rk8.z); kv[6] = bfl(rk8.w); kv[7] = bfh(rk8.w); \
        av[0] = bfl(ra8.x); av[1] = bfh(ra8.x); av[2] = bfl(ra8.y); av[3] = bfh(ra8.y); av[4] = bfl(ra8.z); av[5] = bfh(ra8.z); av[6] = bfl(ra8.w); av[7] = bfh(ra8.w); \
        rv[0] = bfl(rr8.x); rv[1] = bfh(rr8.x); rv[2] = bfl(rr8.y); rv[3] = bfh(rr8.y); rv[4] = bfl(rr8.z); rv[5] = bfh(rr8.z); rv[6] = bfl(rr8.w); rv[7] = bfh(rr8.w); \
        lv[0] = rl0.x; lv[1] = rl0.y; lv[2] = rl0.z; lv[3] = rl0.w; lv[4] = rl1.x; lv[5] = rl1.y; lv[6] = rl1.z; lv[7] = rl1.w; \
        float kkv[8], ss = 0.f, bs = 0.f; \
        _Pragma("unroll") for (int i = 0; i < 8; ++i) { kkv[i] = kv[i] * kkc[i]; ss += kkv[i] * kkv[i]; } \
        ss = oct_sum(ss); const float inv = 1.0f / fmaxf(sqrtf(ss), 1e-12f); \
        float ow[8], ok[8], ob[8], oa[8]; \
        _Pragma("unroll") for (int i = 0; i < 8; ++i) { const float kk = kkv[i] * inv; ok[i] = kv[i] * (1.0f + (av[i] - 1.0f) * kac[i]); oa[i] = -kk; ob[i] = kk * av[i]; ow[i] = __expf(lv[i]); bs += rv[i] * ok[i] * rkc[i]; } \
        bs = oct_sum(bs); \
        if (rq == 0 && part == 0) BON[(row0 + (size_t)(c) * TC + tk) * 16 + h] = DBG_BONV; \
        LAS float* d_ = B_ + tk * 64 + 8 * part; \
        *(LAS f32x4*)(d_) = (f32x4){ow[0], ow[1], ow[2], ow[3]}; *(LAS f32x4*)(d_ + 4) = (f32x4){ow[4], ow[5], ow[6], ow[7]}; d_ += TC * 64; \
        *(LAS f32x4*)(d_) = (f32x4){ok[0], ok[1], ok[2], ok[3]}; *(LAS f32x4*)(d_ + 4) = (f32x4){ok[4], ok[5], ok[6], ok[7]}; d_ += TC * 64; \
        *(LAS f32x4*)(d_) = (f32x4){ob[0], ob[1], ob[2], ob[3]}; *(LAS f32x4*)(d_ + 4) = (f32x4){ob[4], ob[5], ob[6], ob[7]}; d_ += TC * 64; \
        *(LAS f32x4*)(d_) = (f32x4){oa[0], oa[1], oa[2], oa[3]}; *(LAS f32x4*)(d_ + 4) = (f32x4){oa[4], oa[5], oa[6], oa[7]}; d_ += TC * 64; \
        *(LAS f32x4*)(d_) = (f32x4){rv[0], rv[1], rv[2], rv[3]}; *(LAS f32x4*)(d_ + 4) = (f32x4){rv[4], rv[5], rv[6], rv[7]}; \
        if (part < 2) { LAS float* dv_ = B_ + 5 * TC * 64 + tk * 16 + 8 * part; \
            *(LAS f32x4*)(dv_) = (f32x4){bfl(rv8.x), bfh(rv8.x), bfl(rv8.y), bfh(rv8.y)}; *(LAS f32x4*)(dv_ + 4) = (f32x4){bfl(rv8.z), bfh(rv8.z), bfl(rv8.w), bfh(rv8.w)}; } } while (0)
                SCAN_LOAD(0); SCAN_STAGE(0); SCAN_LOAD(1);
                __syncthreads();
                for (int c = 0; c < NCH; ++c) {
                    if (c + 1 < NCH) { SCAN_STAGE(c + 1); }
                    if (c + 2 < NCH) { SCAN_LOAD(c + 2); }
                    if (c > 0) { const LAS float* ys = YS + ((c - 1) & 1) * (TC * 16) + tk * 16 + 2 * part; const float y0 = ys[0], y1 = ys[1];
                        float* yo = Yf + (row0 + (size_t)(c - 1) * TC + tk) * 1024 + h * 64 + 16 * rq + 2 * part; *(GAS f32x2*)yo = (f32x2){y0, y1}; }
                    __syncthreads();
                }
                { const LAS float* ys = YS + ((NCH - 1) & 1) * (TC * 16) + tk * 16 + 2 * part; const float y0 = ys[0], y1 = ys[1];
                  float* yo = Yf + (row0 + (size_t)(NCH - 1) * TC + tk) * 1024 + h * 64 + 16 * rq + 2 * part; *(GAS f32x2*)yo = (f32x2){y0, y1}; }
#undef SCAN_LOAD
#undef SCAN_STAGE
            } else {
                const int rl = lane >> 4, jq = lane & 15, il = 4 * wave + rl;
                float s0 = 0.f, s1 = 0.f, s2 = 0.f, s3 = 0.f;
                __syncthreads();
                for (int c = 0; c < NCH; ++c) {
                    const LAS float* B_ = SB + (c & 1) * BUF_F; LAS float* ys = YS + (c & 1) * (TC * 16);
#pragma unroll 4
                    for (int t = 0; t < TC; ++t) {
                        const f32x4 w4 = *(const LAS f32x4*)(B_ + t * 64 + 4 * jq), k4 = *(const LAS f32x4*)(B_ + TC * 64 + t * 64 + 4 * jq), b4 = *(const LAS f32x4*)(B_ + 2 * TC * 64 + t * 64 + 4 * jq),
                                    a4 = *(const LAS f32x4*)(B_ + 3 * TC * 64 + t * 64 + 4 * jq), r4 = *(const LAS f32x4*)(B_ + 4 * TC * 64 + t * 64 + 4 * jq);
                        const float v = B_[5 * TC * 64 + t * 16 + il];
                        float sa = (s0 * a4.x + s1 * a4.y) + (s2 * a4.z + s3 * a4.w);
                        sa = row16_sum(sa);
                        s0 = s0 * w4.x + (sa * b4.x + v * k4.x); s1 = s1 * w4.y + (sa * b4.y + v * k4.y); s2 = s2 * w4.z + (sa * b4.z + v * k4.z); s3 = s3 * w4.w + (sa * b4.w + v * k4.w);
                        float y = (s0 * r4.x + s1 * r4.y) + (s2 * r4.z + s3 * r4.w);
                        y = row16_sum(y);
                        if (jq == 0) ys[t * 16 + il] = y;
                    }
                    __syncthreads();
                }
            }
            __syncthreads();
        }
        SEAM();
    }

    if (IN(5)) { PH_BEGIN();
        float lam;
        { const float a1 = INP(5)[lane] * INP(6)[lane], a2 = INP(7)[lane] * INP(8)[lane]; lam = __expf(wave_sum(a1)) - __expf(wave_sum(a2)) + 0.2f; }
        const float* sg = INP(9); const float* lng = INP(19); const float* lnb = INP(20);
        float sgl[16], lgl[16], lbl[16];
#pragma unroll
        for (int i = 0; i < 16; ++i) { sgl[i] = sg[16 * (lane & 7) + i] * 0.8f; lgl[i] = lng[16 * lane + i]; lbl[i] = lnb[16 * lane + i]; }
        for (int m = gw; m < T_; m += NGW) {
            {
                const int h = lane >> 3; const bfu* p0 = Ob + (size_t)m * 2048 + (2 * h) * 128 + 16 * (lane & 7); const bfu* p1 = p0 + 128;
                float o0[16], o1[16]; unpack16(*(const GAS v4u*)p0, *(const GAS v4u*)(p0 + 8), o0); unpack16(*(const GAS v4u*)p1, *(const GAS v4u*)(p1 + 8), o1);
                float ss = 0.f;
#pragma unroll
                for (int i = 0; i < 16; ++i) { o0[i] = o0[i] - lam * o1[i]; ss += o0[i] * o0[i]; }
                ss = oct_sum(ss);
                const float rstd = 1.0f / sqrtf(ss * (1.f / 128.f) + 1e-5f);
#pragma unroll
                for (int i = 0; i < 16; ++i) o0[i] = o0[i] * rstd * sgl[i];
                v4u oa, ob; pack16(o0, oa, ob); bfu* po = YAb + (size_t)m * 1024 + 16 * lane; *(GAS v4u*)po = oa; *(GAS v4u*)(po + 8) = ob;
            }
            {
                const float* yp = Yf + (size_t)m * 1024 + 16 * lane; float y[16];
#pragma unroll
                for (int i = 0; i < 4; ++i) { const f32x4 t = *(const GAS f32x4*)(yp + 4 * i); y[4 * i] = t.x; y[4 * i + 1] = t.y; y[4 * i + 2] = t.z; y[4 * i + 3] = t.w; }
#ifdef DBG_Y0
#pragma unroll
                for (int i = 0; i < 16; ++i) y[i] = (float)((i * 7 + lane) & 15) * 0.1f;
#endif
                float s = 0.f;
#pragma unroll
                for (int i = 0; i < 16; ++i) s += y[i];
                const float mean = quad_sum(s) * (1.f / 64.f); float q = 0.f;
#pragma unroll
                for (int i = 0; i < 16; ++i) { y[i] -= mean; q += y[i] * y[i]; }
                const float rstd = 1.0f / sqrtf(quad_sum(q) * (1.f / 64.f) + 64e-5f);
#ifdef DBG_BON0
                float bon; { const bfu* pa = ASb + (size_t)m * 1024 + 16 * lane; float aa[16]; unpack16(*(const GAS v4u*)pa, *(const GAS v4u*)(pa + 8), aa); float sa_ = 0.f;
#pragma unroll
                  for (int i = 0; i < 16; ++i) sa_ += aa[i] * (float)(i + 1); bon = quad_sum(sa_) * 0.01f; }
#else
                const float bon = BON[(size_t)m * 16 + (lane >> 2)];
#endif
                float vv[16], gg[16]; const bfu* pv = VSb + (size_t)m * 1024 + 16 * lane; const bfu* pg = GGb + (size_t)m * 1024 + 16 * lane;
                unpack16(*(const GAS v4u*)pv, *(const GAS v4u*)(pv + 8), vv); unpack16(*(const GAS v4u*)pg, *(const GAS v4u*)(pg + 8), gg);
#pragma unroll
                for (int i = 0; i < 16; ++i) y[i] = (y[i] * rstd * lgl[i] + lbl[i] + bon * vv[i]) * gg[i];
                v4u oa, ob; pack16(y, oa, ob); bfu* po = YBb + (size_t)m * 1024 + 16 * lane; *(GAS v4u*)po = oa; *(GAS v4u*)(po + 8) = ob;
            }
        }
        SEAM();
    }

    if (IN(6)) { PH_BEGIN();
        { pg8::Gemm g{YAb, WPAt, 1024, 1024}; pg8::StaticOrder S; S.init(T_, 2048, G, bx); pg8::EpiProj<0> E{Gb, 0, TMPb, MRGb};
          pg8::gemm_phase<pg8::EpiProj<0>, pg8::StaticOrder, true, true>(L + RING_OFF, g, S, E); }
        { pg8::Gemm g{YBb, WPBt, 1024, 1024}; pg8::StaticOrder S; S.init(T_, 2048, G, bx); pg8::EpiProj<1> E{Gb, 2048, TMPb, MRGb};
          pg8::gemm_phase<pg8::EpiProj<1>, pg8::StaticOrder, true, true>(L + RING_OFF, g, S, E); }
        SEAM();
    }

    if (IN(7)) { PH_BEGIN();
        pg8::Gemm g{MRGb, WOUTt, 2048, 2048}; pg8::StaticOrder S; S.init(T_, 2048, G, bx); pg8::EpiRes E{INP(0), OUTP};
        pg8::gemm_phase<pg8::EpiRes, pg8::StaticOrder, true, true>(L + RING_OFF, g, S, E);
        SEAM();
    }

    if (IN(8)) { PH_BEGIN();
        for (int m = gw; m < T_; m += NGW) rms_row_to_bf16(OUTP + (size_t)m * 2048, INP(24), Hb + (size_t)m * 2048, lane, 1e-6f);
        LAS float* scr = (LAS float*)(L + RING_OFF + wave * 16384);
        const float* wg = INP(29); const float* wu = INP(30); const float* wd = INP(31);
        for (int it = gw; it < 2 * 32 * 1024; it += NGW) { const int up = it >> 15, r = it & 32767, e = r >> 10, kb = (r >> 5) & 31, nb = r & 31, n0 = 32 * nb;
            transpose_item((up ? wu : wg) + (size_t)e * 2048 * 1024, 1024, 64 * kb, n0, WGUt, 2048, (size_t)e * 2048 + (n0 >> 7) * 256 + (n0 & 127) + up * 128, scr, lane); }
        for (int it = gw; it < 32 * 1024; it += NGW) { const int e = it >> 10, kb = (it >> 6) & 15, nb = it & 63, n0 = 32 * nb;
            transpose_item(wd + (size_t)e * 1024 * 2048, 2048, 64 * kb, n0, WDt, 1024, (size_t)e * 2048 + n0, scr, lane); }
        SEAM();
    }

    if (IN(9)) { PH_BEGIN();
        pg8::Gemm g{Hb, WRTt, 512, 2048}; pg8::RouterOrder S{G, bx}; pg8::EpiRouter E{LOGIT};
        pg8::gemm_phase<pg8::EpiRouter, pg8::RouterOrder, true, true>(L + RING_OFF, g, S, E);
        SEAM();
    }

    if (IN(10)) { PH_BEGIN();
        if (bx < 32) {
            LAS unsigned* hist = (LAS unsigned*)(L + RING_OFF); LAS unsigned* base = hist + 32;
            if (tid < 32) hist[tid] = 0u;
            __syncthreads();
            const int tok = bx * 512 + tid;
            float lg[36];
#pragma unroll
            for (int c4 = 0; c4 < 9; ++c4) { f32x4 s = (f32x4){0.f, 0.f, 0.f, 0.f};
#pragma unroll
                for (int kq = 0; kq < 4; ++kq) s += *(const GAS f32x4*)(LOGIT + ((size_t)kq * T_ + tok) * 64 + 4 * c4);
                lg[4 * c4] = s.x; lg[4 * c4 + 1] = s.y; lg[4 * c4 + 2] = s.z; lg[4 * c4 + 3] = s.w; }
            const float* bg = INP(26); const float* be = INP(28);
            int gi = 0; float gm = lg[0] + bg[0]; float gl[4];
#pragma unroll
            for (int i = 0; i < 4; ++i) { gl[i] = lg[i] + bg[i]; if (gl[i] > gm) { gm = gl[i]; gi = i; } }
            float gs = 0.f;
#pragma unroll
            for (int i = 0; i < 4; ++i) gs += __expf(gl[i] - gm);
            const float pg = 1.0f / gs;
            float el[8];
#pragma unroll
            for (int j = 0; j < 8; ++j) { float v = 0.f;
#pragma unroll
                for (int gg = 0; gg < 4; ++gg) v = (gg == gi) ? (lg[4 + gg * 8 + j] + be[gg * 8 + j]) : v;
                el[j] = v; }
            int i1 = 0; float m1 = el[0];
#pragma unroll
            for (int j = 1; j < 8; ++j) if (el[j] > m1) { m1 = el[j]; i1 = j; }
            int i2 = -1; float m2 = -INFINITY;
#pragma unroll
            for (int j = 0; j < 8; ++j) if (j != i1 && el[j] > m2) { m2 = el[j]; i2 = j; }
            const float p2 = __expf(m2 - m1); const float g1 = pg / (1.0f + p2), g2 = pg * p2 / (1.0f + p2);
            const int e1 = gi * 8 + i1, e2 = gi * 8 + i2;
            const unsigned q1 = atomicAdd((unsigned*)(hist + e1), 1u), q2 = atomicAdd((unsigned*)(hist + e2), 1u);
            __syncthreads();
            if (tid < 32) base[tid] = __hip_atomic_fetch_add((unsigned*)(ctl + CW_CNT + tid), hist[tid], __ATOMIC_RELAXED, __HIP_MEMORY_SCOPE_AGENT);
            __syncthreads();
            ASG_E[2 * tok] = e1; ASG_E[2 * tok + 1] = e2; ASG_POS[2 * tok] = (int)(base[e1] + q1); ASG_POS[2 * tok + 1] = (int)(base[e2] + q2); ASG_GATE[2 * tok] = g1; ASG_GATE[2 * tok + 1] = g2;
        }
        SEAM();
    }

#define TT ((LAS int*)(L + TT_OFF))
    if (IN(11) || IN(12) || IN(13)) { PH_BEGIN();
        if (tid == 0) { int off = 0, nt = 0;
            for (int e = 0; e < 32; ++e) { const int c = (int)__hip_atomic_load((unsigned*)(ctl + CW_CNT + e), __ATOMIC_RELAXED, __HIP_MEMORY_SCOPE_AGENT); TT[e] = off; const int n = (c + 255) >> 8; for (int k = 0; k < n; ++k) TT[33 + nt + k] = e; nt += n; off += n * 256; }
            TT[32] = nt; }
        __syncthreads();
    }
    if (IN(11)) { PH_BEGIN();
        for (int a = gw; a < 2 * T_; a += NGW) { const int t = a >> 1, e = ASG_E[a]; const int dest = TT[e] + ASG_POS[a];
            const GAS v4u* src = (const GAS v4u*)(Hb + (size_t)t * 2048) + lane; GAS v4u* dst = (GAS v4u*)(XGb + (size_t)dest * 2048) + lane;
#pragma unroll
            for (int j = 0; j < 4; ++j) dst[64 * j] = src[64 * j];
            if (lane == 0) { ROWGATE[dest] = ASG_GATE[a]; TOKDEST[a] = dest; } }
        SEAM();
    }

    if (IN(12)) { PH_BEGIN();
        const int ntiles = TT[32];
        pg8::Gemm g{XGb, WGUt, 2048, 2048}; pg8::MoeOrder S; S.so.init(ntiles * 256, 2048, G, bx); S.tile_e = (const LAS int*)(TT + 33); pg8::EpiGU E{ACTb};
        pg8::gemm_phase<pg8::EpiGU, pg8::MoeOrder, true, true>(L + RING_OFF, g, S, E);
        SEAM();
    }
    if (IN(13)) { PH_BEGIN();
        const int ntiles = TT[32];
        pg8::Gemm g{ACTb, WDt, 1024, 1024}; pg8::MoeOrder S; S.so.init(ntiles * 256, 2048, G, bx); S.tile_e = (const LAS int*)(TT + 33); pg8::EpiDown E{YDb, ROWGATE};
        pg8::gemm_phase<pg8::EpiDown, pg8::MoeOrder, true, true>(L + RING_OFF, g, S, E);
        SEAM();
    }
    if (IN(14)) { PH_BEGIN();
        for (int m = gw; m < T_; m += NGW) { const int d0 = TOKDEST[2 * m], d1 = TOKDEST[2 * m + 1];
            GAS f32x4* o = (GAS f32x4*)(OUTP + (size_t)m * 2048) + lane; const GAS u32x2* y0 = (const GAS u32x2*)(YDb + (size_t)d0 * 2048) + lane; const GAS u32x2* y1 = (const GAS u32x2*)(YDb + (size_t)d1 * 2048) + lane;
#pragma unroll
            for (int j = 0; j < 8; ++j) { f32x4 v = o[64 * j]; const u32x2 a = y0[64 * j], b = y1[64 * j];
                v.x += bfl(a.x) + bfl(b.x); v.y += bfh(a.x) + bfh(b.x); v.z += bfl(a.y) + bfl(b.y); v.w += bfh(a.y) + bfh(b.y); o[64 * j] = v; } }
    }
#undef IN
#undef SEAM
}

#ifndef N_PHASES_
#define N_PHASES_ 15
#endif
constexpr int N_PHASES = N_PHASES_;
extern "C" void kernel_launch(void* const* d_in, const int* in_sizes, int n_in, void* d_out, int out_size, void* d_ws, size_t ws_size, hipStream_t stream) {
    static int grid = 0;
    if (grid == 0) {
        if (n_in != 32 || out_size != T_ * DMODEL || ws_size < WS_END) { fprintf(stderr, "kernel_launch: unexpected problem (n_in %d, out %d, ws %zu)\n", n_in, out_size, ws_size); grid = -1; return; }
        int dev = 0, cus = 0, per_cu = 0;
        if (hipGetDevice(&dev) != hipSuccess || hipDeviceGetAttribute(&cus, hipDeviceAttributeMultiprocessorCount, dev) != hipSuccess) { grid = -1; return; }
        if (hipFuncSetAttribute((const void*)mk_fwd, hipFuncAttributeMaxDynamicSharedMemorySize, LDS_BYTES) != hipSuccess) { fprintf(stderr, "kernel_launch: hipFuncSetAttribute failed\n"); grid = -1; return; }
        if (hipOccupancyMaxActiveBlocksPerMultiprocessor(&per_cu, (const void*)mk_fwd, NWAVES * 64, LDS_BYTES) != hipSuccess || per_cu < 1) fprintf(stderr, "kernel_launch: occupancy query reports %d\n", per_cu);
        (void)hipGetLastError();
        grid = cus;
    }
    if (grid < 0) return;
    if (hipMemsetAsync((char*)d_ws + WS_CTL, 0, CTL_ZERO_BYTES, stream) != hipSuccess) return;
    Args a{};
    for (int i = 0; i < 32; ++i) a.in[i] = (const float*)d_in[i];
    a.out = (float*)d_out; a.ws = (unsigned char*)d_ws;
#if MK_SPLIT
    for (int p = 0; p < N_PHASES; ++p) { a.ph_lo = p; a.ph_hi = p + 1; hipLaunchKernelGGL(mk_fwd, dim3(grid), dim3(NWAVES * 64), LDS_BYTES, stream, a); }
#else
    a.ph_lo = 0; a.ph_hi = N_PHASES; hipLaunchKernelGGL(mk_fwd, dim3(grid), dim3(NWAVES * 64), LDS_BYTES, stream, a);
#endif
}
```

```cpp
#include <hip/hip_runtime.h>
#include <hip/hip_bf16.h>
#include <cstdio>
#include <cstdint>
#include <cmath>

#ifndef WOUT_F8
#define WOUT_F8 0
#endif
#ifndef DBG_ACC
#define DBG_ACC(x) (x)
#endif
#ifndef MK_SPLIT
#define MK_SPLIT 0
#endif

namespace pg8 {
#define PG8_LAS __attribute__((address_space(3)))
typedef unsigned short bf16_t;
typedef short bf16x8 __attribute__((ext_vector_type(8)));
typedef float f32x4 __attribute__((ext_vector_type(4)));
typedef unsigned u32x4 __attribute__((ext_vector_type(4)));
constexpr int BM = 256, BK = 64, HALF = 128, HTB = HALF * BK * 2  , STAGE_BYTES = 8 * HTB, NXCD = 8, WGM = 8;

__host__ __device__ __forceinline__ int lds_byte(int r, int c) { const int st = (r >> 4) * 2 + (c >> 5), rr = r & 15, cc = c & 31, ob = rr * 64 + cc * 2; return st * 1024 + (ob ^ (((ob >> 9) & 1) << 5)); }
__host__ __device__ __forceinline__ void stage_rc(int b, int& R, int& C) { const int st = b / 1024, sb = b % 1024, swz = sb ^ (((sb >> 9) & 1) << 5); R = (st >> 1) * 16 + swz / 64; C = (st & 1) * 32 + (swz % 64) / 2; }
__host__ __device__ __forceinline__ int perm32(int rho) { const int n = rho >> 4, i = rho & 15; return 8 * (i >> 2) + 4 * n + (i & 3); }

struct Unit { int pm, pn, pb, ko; };
struct Gemm { const bf16_t* A; const bf16_t* Bt; int K, ld; };

struct StaticOrder {
    int nM, nN, nwg, G, c;
    __host__ __device__ void init(int M, int N, int G_, int c_) { nM = M / BM; nN = N / BM; nwg = nM * nN; G = G_; c = c_; }
    __host__ __device__ bool next(int i, Unit& u) const { return at(i * G + c, u); }
    __host__ __device__ bool at(int L, Unit& u) const {
        if (L >= nwg) return false;
        int wgid = L; { const int q = nwg / NXCD, r = nwg % NXCD, xcd = wgid % NXCD, off = wgid / NXCD; wgid = (xcd < r ? xcd * (q + 1) : r * (q + 1) + (xcd - r) * q) + off; }
        return at_w(wgid, u);
    }
    __host__ __device__ bool at_w(int wgid, Unit& u) const {
        const int nig = WGM * nN, gid = wgid / nig, fm = gid * WGM, gsz = (nM - fm) < WGM ? (nM - fm) : WGM;
        u.pm = fm + ((wgid % nig) % gsz); u.pn = (wgid % nig) / gsz; u.pb = u.pn; u.ko = 0; return true;
    }
};
struct WinOrder {
    StaticOrder so; int f8;
    __device__ __forceinline__ bool next(int i, Unit& u) const {
        bool ok;
        if (so.G == 256) { const int x = so.c & 7, o = i * 32 + (so.c >> 3);
            const int cnt = f8 ? (x < 4 ? 128 : 192) : (x < 4 ? 192 : 160), start = f8 ? (x < 4 ? 128 * x : 512 + 192 * (x - 4)) : (x < 4 ? 192 * x : 768 + 160 * (x - 4));
            ok = (o < cnt) && so.at_w(start + o, u); }
        else ok = so.next(i, u);
        if (!ok) return false;
        const int p = u.pn; u.pn = f8 ? (p < 4 ? 8 + p : 22 + p) : (p < 8 ? p : p + 4); u.pb = u.pn; return true; }
};
struct LoraOrder {
    StaticOrder so;
    __device__ __forceinline__ bool next(int i, Unit& u) const { if (!so.next(i, u)) return false; u.pb = (u.pm >> 6) * 4 + u.pn; return true; }
};
struct RouterOrder {
    int G, c;
    __device__ __forceinline__ bool next(int i, Unit& u) const { const int L = i * G + c; if (L >= 256) return false; u.pm = L >> 2; u.pn = 0; u.pb = 0; u.ko = (L & 3) * 512; return true; }
};
struct MoeOrder {
    StaticOrder so; const PG8_LAS int* tile_e;
    __device__ __forceinline__ bool next(int i, Unit& u) const { if (!so.next(i, u)) return false; u.pb = __builtin_amdgcn_readfirstlane(tile_e[u.pm]) * 8 + u.pn; return true; }
};

typedef float f32x2_t __attribute__((ext_vector_type(2))); typedef __bf16 bf16x2_t __attribute__((ext_vector_type(2)));
__device__ __forceinline__ unsigned cvt_pk_bf16(float lo, float hi) { f32x2_t v = {lo, hi}; bf16x2_t b = __builtin_convertvector(v, bf16x2_t); return __builtin_bit_cast(unsigned, b); }
__device__ __forceinline__ float bf_lo(unsigned w) { return __uint_as_float(w << 16); }
__device__ __forceinline__ float bf_hi(unsigned w) { return __uint_as_float(w & 0xffff0000u); }
__device__ __forceinline__ float sigmoidf_(float x) { return __builtin_amdgcn_rcpf(1.0f + __expf(-x)); }
__device__ __forceinline__ u32x4 pack8(const f32x4 v0, const f32x4 v1) { u32x4 w; w.x = cvt_pk_bf16(v0[0], v0[1]); w.y = cvt_pk_bf16(v0[2], v0[3]); w.z = cvt_pk_bf16(v1[0], v1[1]); w.w = cvt_pk_bf16(v1[2], v1[3]); return w; }
__device__ __forceinline__ void unpack8(const u32x4 w, f32x4& v0, f32x4& v1) { v0 = (f32x4){bf_lo(w.x), bf_hi(w.x), bf_lo(w.y), bf_hi(w.y)}; v1 = (f32x4){bf_lo(w.z), bf_hi(w.z), bf_lo(w.w), bf_hi(w.w)}; }

__device__ __forceinline__ float clamp_f8(float x) { return __builtin_amdgcn_fmed3f(x, -448.f, 448.f); }
__device__ __forceinline__ unsigned pk4_fp8(float a, float b, float c, float d) { int w = 0; w = __builtin_amdgcn_cvt_pk_fp8_f32(clamp_f8(a), clamp_f8(b), w, false); w = __builtin_amdgcn_cvt_pk_fp8_f32(clamp_f8(c), clamp_f8(d), w, true); return (unsigned)w; }
typedef unsigned u32x2_ __attribute__((ext_vector_type(2)));

#define PG8_EPI_LOOP_BEGIN \
    _Pragma("unroll") for (int ai = 0; ai < 2; ++ai) _Pragma("unroll") for (int m = 0; m < 4; ++m) { const int row = u.pm * BM + ai * HALF + wr * 64 + m * 16 + fr; \
        _Pragma("unroll") for (int bj = 0; bj < 2; ++bj) { const int colr = bj * HALF + wc * 32 + 8 * fq; f32x4 v0 = acc[ai][bj][m][0], v1 = acc[ai][bj][m][1];
#define PG8_EPI_LOOP_END } }

struct EpiWin {
    static constexpr bool PERM = true;
    bf16_t *Q, *K, *V, *RW, *G; float sc;
    __device__ __forceinline__ void operator()(const f32x4 (&acc)[2][2][4][2], const Unit& u, int wr, int wc, int fr, int fq) const {
        bf16_t* base; int ldc, colt; const int pn = u.pn;
        if (pn < 4) { base = Q; ldc = 1024; colt = pn * 256; } else if (pn < 8) { base = K; ldc = 1024; colt = (pn - 4) * 256; } else if (pn < 12) { base = V; ldc = 1024; colt = (pn - 8) * 256; }
        else if (pn < 26) { base = RW; ldc = 3584; colt = (pn - 12) * 256; } else { base = G; ldc = 4096; colt = (pn - 26) * 256; }
        PG8_EPI_LOOP_BEGIN
            *(u32x4*)(base + (size_t)row * ldc + colt + colr) = pack8(v0 * sc, v1 * sc);
        PG8_EPI_LOOP_END
    }
};
struct EpiLora {
    static constexpr bool PERM = true;
    float* LD; bf16_t* AS; bf16_t* GG; const float* w0; const float* a0;
    __device__ __forceinline__ void operator()(const f32x4 (&acc)[2][2][4][2], const Unit& u0, int wr, int wc, int fr, int fq) const {
        const int which = u0.pm >> 6; Unit u = u0; u.pm = u0.pm & 63; const int colt = u.pn * 256;
        PG8_EPI_LOOP_BEGIN
            const int col = colt + colr; const size_t off = (size_t)row * 1024 + col;
            if (which == 0) { const f32x4 b0 = *(const f32x4*)(w0 + col), b1 = *(const f32x4*)(w0 + col + 4); f32x4 o0, o1;
#pragma unroll
                for (int j = 0; j < 4; ++j) { float z = -(v0[j] + b0[j]); float sp = fmaxf(z, 0.f) + __logf(1.0f + __expf(-fabsf(z))); o0[j] = -__expf(-sp - 0.5f);
                                              z = -(v1[j] + b1[j]); sp = fmaxf(z, 0.f) + __logf(1.0f + __expf(-fabsf(z))); o1[j] = -__expf(-sp - 0.5f); }
                *(f32x4*)(LD + off) = o0; *(f32x4*)(LD + off + 4) = o1; }
            else if (which == 1) { const f32x4 b0 = *(const f32x4*)(a0 + col), b1 = *(const f32x4*)(a0 + col + 4);
#pragma unroll
                for (int j = 0; j < 4; ++j) { v0[j] = sigmoidf_(DBG_ACC(v0[j]) + b0[j]); v1[j] = sigmoidf_(DBG_ACC(v1[j]) + b1[j]); }
                *(u32x4*)(AS + off) = pack8(v0, v1); }
            else { *(u32x4*)(GG + off) = pack8(v0, v1); }
        PG8_EPI_LOOP_END
    }
};
template <int MODE> struct EpiProj {
    static constexpr bool PERM = true;
    const bf16_t* G; int goff; bf16_t* TMP; bf16_t* OUT; float osc;
    __device__ __forceinline__ void operator()(const f32x4 (&acc)[2][2][4][2], const Unit& u, int wr, int wc, int fr, int fq) const {
        const int colt = u.pn * 256;
        PG8_EPI_LOOP_BEGIN
            const int col = colt + colr; const u32x4 gw = *(const u32x4*)(G + (size_t)row * 4096 + goff + col); f32x4 g0, g1; unpack8(gw, g0, g1);
#pragma unroll
            for (int j = 0; j < 4; ++j) { v0[j] *= sigmoidf_(g0[j]); v1[j] *= sigmoidf_(g1[j]); }
#ifdef DBG_NO_YA
            if (MODE == 0) { v0 *= 0.f; v1 *= 0.f; }
#endif
#ifdef DBG_NO_YB
            if (MODE == 1) { v0 *= 0.f; v1 *= 0.f; }
#endif
            if (MODE == 1) { const u32x4 tw = *(const u32x4*)(TMP + (size_t)row * 2048 + col); f32x4 t0, t1; unpack8(tw, t0, t1); v0 = (v0 + t0) * osc; v1 = (v1 + t1) * osc;
                if (WOUT_F8) { u32x2_ w; w.x = pk4_fp8(v0[0], v0[1], v0[2], v0[3]); w.y = pk4_fp8(v1[0], v1[1], v1[2], v1[3]); *(u32x2_*)((unsigned char*)OUT + (size_t)row * 2048 + col) = w; }
                else *(u32x4*)(OUT + (size_t)row * 2048 + col) = pack8(v0, v1); }
            else *(u32x4*)(TMP + (size_t)row * 2048 + col) = pack8(v0, v1);
        PG8_EPI_LOOP_END
    }
};
struct EpiRes {
    static constexpr bool PERM = true;
    const float* X; float* O; float sc;
    __device__ __forceinline__ void operator()(const f32x4 (&acc)[2][2][4][2], const Unit& u, int wr, int wc, int fr, int fq) const {
        const int colt = u.pn * 256;
        PG8_EPI_LOOP_BEGIN
            const size_t off = (size_t)row * 2048 + colt + colr;
            *(f32x4*)(O + off) = v0 * sc + *(const f32x4*)(X + off); *(f32x4*)(O + off + 4) = v1 * sc + *(const f32x4*)(X + off + 4);
        PG8_EPI_LOOP_END
    }
};
struct EpiBf16 {
    static constexpr bool PERM = true;
    bf16_t* O; int ldc; float sc;
    __device__ __forceinline__ void operator()(const f32x4 (&acc)[2][2][4][2], const Unit& u, int wr, int wc, int fr, int fq) const {
        const int colt = u.pn * 256;
        PG8_EPI_LOOP_BEGIN
            *(u32x4*)(O + (size_t)row * ldc + colt + colr) = pack8(v0 * sc, v1 * sc);
        PG8_EPI_LOOP_END
    }
};
struct EpiRouter {
    static constexpr bool PERM = true;
    float* LG;
    __device__ __forceinline__ void operator()(const f32x4 (&acc)[2][2][4][2], const Unit& u, int wr, int wc, int fr, int fq) const {
        float* base = LG + (size_t)(u.ko >> 9) * 16384 * 64;
        PG8_EPI_LOOP_BEGIN
            if (bj == 0 && wc < 2) { float* p = base + (size_t)row * 64 + colr; *(f32x4*)p = v0; *(f32x4*)(p + 4) = v1; }
        PG8_EPI_LOOP_END
    }
};
struct EpiGU {
    static constexpr bool PERM = true;
    unsigned char* ACT; float sc_in, sc_out;
    __device__ __forceinline__ void operator()(const f32x4 (&acc)[2][2][4][2], const Unit& u, int wr, int wc, int fr, int fq) const {
#pragma unroll
        for (int ai = 0; ai < 2; ++ai)
#pragma unroll
            for (int m = 0; m < 4; ++m) { const int row = u.pm * BM + ai * HALF + wr * 64 + m * 16 + fr; const int col = u.pn * 128 + wc * 32 + 8 * fq;
                f32x4 g0 = acc[ai][0][m][0] * sc_in, g1 = acc[ai][0][m][1] * sc_in; const f32x4 u0 = acc[ai][1][m][0] * (sc_in * sc_out), u1 = acc[ai][1][m][1] * (sc_in * sc_out);
#pragma unroll
                for (int j = 0; j < 4; ++j) { g0[j] = g0[j] * sigmoidf_(g0[j]) * u0[j]; g1[j] = g1[j] * sigmoidf_(g1[j]) * u1[j]; }
                u32x2_ w; w.x = pk4_fp8(g0[0], g0[1], g0[2], g0[3]); w.y = pk4_fp8(g1[0], g1[1], g1[2], g1[3]);
                *(u32x2_*)(ACT + (size_t)row * 1024 + col) = w; }
    }
};
struct EpiDown {
    static constexpr bool PERM = true;
    bf16_t* YD; const float* gate; float sc_in;
    __device__ __forceinline__ void operator()(const f32x4 (&acc)[2][2][4][2], const Unit& u, int wr, int wc, int fr, int fq) const {
        const int colt = u.pn * 256;
        PG8_EPI_LOOP_BEGIN
            const float gt = gate[row] * sc_in; v0 *= gt; v1 *= gt;
            *(u32x4*)(YD + (size_t)row * 2048 + colt + colr) = pack8(v0, v1);
        PG8_EPI_LOOP_END
    }
};

template <class Epi, class Sched, bool ALIGN_EPI = false, bool SP2 = false>
__device__ __forceinline__ void gemm_phase(PG8_LAS unsigned char* lds, const Gemm g, const Sched& S, const Epi& E) {
    int tid_ = threadIdx.x; asm volatile("" : "+v"(tid_));
    const int tid = tid_, wid = __builtin_amdgcn_readfirstlane(tid >> 6), lane = tid & 63, wr = wid >> 2, wc = wid & 3, fr = lane & 15, fq = lane >> 4;
    const int K = g.K, nt = K / BK, LD = g.ld;
    unsigned voffA[2], voffB[2];
#pragma unroll
    for (int i = 0; i < 2; ++i) { int R, C; stage_rc(tid * 16 + i * 8192, R, C); const int Rb = Epi::PERM ? ((R & ~31) + perm32(R & 31)) : R;
        voffA[i] = (unsigned)(R * LD + C) * 2u; voffB[i] = (unsigned)(Rb * LD + C) * 2u; }
    const size_t kstep = (size_t)(BK * 2);
    const size_t hstep = (size_t)HALF * LD * 2;
    const size_t tstep = 2 * hstep;
    const unsigned ldsw = (unsigned)wid * 1024u;
    const int aoff = lds_byte(wr * 64 + fr, fq * 8), boff = lds_byte(wc * 32 + fr, fq * 8);
#define PG8_SA(b, h) (((b) * 2 + (h)) * HTB)
#define PG8_SB(b, h) ((4 + (b) * 2 + (h)) * HTB)
#define PG8_STAGE(bufoff, gbase, voff) do { _Pragma("unroll") for (int _i = 0; _i < 2; ++_i) \
        __builtin_amdgcn_global_load_lds((const unsigned*)((const char*)(gbase) + (voff)[_i]), (PG8_LAS unsigned*)(lds + (bufoff) + ldsw + _i * 8192), 16, 0, 0); } while (0)
#define PG8_LDA(dst, b, h) do { _Pragma("unroll") for (int m = 0; m < 4; ++m) _Pragma("unroll") for (int k = 0; k < 2; ++k) dst[m][k] = *(const PG8_LAS bf16x8*)(lds + PG8_SA(b, h) + aoff + m * 2048 + k * 1024); } while (0)
#define PG8_LDB(dst, b, h) do { _Pragma("unroll") for (int n = 0; n < 2; ++n) _Pragma("unroll") for (int k = 0; k < 2; ++k) dst[n][k] = *(const PG8_LAS bf16x8*)(lds + PG8_SB(b, h) + boff + n * 2048 + k * 1024); } while (0)
#define PG8_MMA(ai, bj, At, Bt) do { __builtin_amdgcn_s_setprio(1); _Pragma("unroll") for (int m = 0; m < 4; ++m) _Pragma("unroll") for (int n = 0; n < 2; ++n) _Pragma("unroll") for (int k = 0; k < 2; ++k) \
        acc[ai][bj][m][n] = __builtin_amdgcn_mfma_f32_16x16x32_bf16(Bt[n][k], At[m][k], acc[ai][bj][m][n], 0, 0, 0); __builtin_amdgcn_s_setprio(0); } while (0)
#define PG8_WAIT_V(n) asm volatile("s_waitcnt vmcnt(" #n ")" ::: "memory")
#define PG8_WAIT_L(n) asm volatile("s_waitcnt lgkmcnt(" #n ")" ::: "memory")
#define PG8_BAR __builtin_amdgcn_s_barrier()
#define PG8_SCHED __builtin_amdgcn_sched_barrier(0)
    Unit cur, nxt; int ui = 0;
    if (!S.next(0, cur)) return;
    f32x4 acc[2][2][4][2];
#pragma unroll
    for (int a = 0; a < 2; ++a)
#pragma unroll
        for (int b = 0; b < 2; ++b)
#pragma unroll
            for (int m = 0; m < 4; ++m)
#pragma unroll
                for (int n = 0; n < 2; ++n) acc[a][b][m][n] = (f32x4){0.f, 0.f, 0.f, 0.f};
    bf16x8 At[4][2], B0[2][2], B1[2][2];
    const char* cA = (const char*)g.A + (size_t)cur.pm * tstep + (size_t)cur.ko * 2; const char* cB = (const char*)g.Bt + (size_t)cur.pb * tstep + (size_t)cur.ko * 2;
    if constexpr (SP2) {
        PG8_STAGE(PG8_SB(0, 0), cB, voffB); PG8_STAGE(PG8_SB(0, 1), cB + hstep, voffB); PG8_STAGE(PG8_SA(0, 0), cA, voffA); PG8_STAGE(PG8_SA(0, 1), cA + hstep, voffA);
        if (wr == 1) PG8_BAR;
        PG8_WAIT_V(2); PG8_BAR;
        PG8_STAGE(PG8_SB(1, 0), cB + kstep, voffB); PG8_STAGE(PG8_SA(1, 0), cA + kstep, voffA); PG8_STAGE(PG8_SB(1, 1), cB + hstep + kstep, voffB);
        PG8_WAIT_V(6); PG8_BAR;
    } else {
        PG8_STAGE(PG8_SB(0, 0), cB, voffB); PG8_STAGE(PG8_SA(0, 0), cA, voffA); PG8_STAGE(PG8_SB(0, 1), cB + hstep, voffB); PG8_STAGE(PG8_SA(0, 1), cA + hstep, voffA);
        if (wr == 1) PG8_BAR;
        PG8_WAIT_V(4); PG8_BAR;
        PG8_STAGE(PG8_SB(1, 0), cB + kstep, voffB); PG8_STAGE(PG8_SA(1, 0), cA + kstep, voffA); PG8_STAGE(PG8_SB(1, 1), cB + hstep + kstep, voffB);
        PG8_WAIT_V(6); PG8_BAR;
    }
    for (;;) {
        const bool has_next = S.next(ui + 1, nxt);
        const char* nA = has_next ? (const char*)g.A + (size_t)nxt.pm * tstep + (size_t)nxt.ko * 2 : cA; const char* nB = has_next ? (const char*)g.Bt + (size_t)nxt.pb * tstep + (size_t)nxt.ko * 2 : cB;
#pragma nounroll
        for (int t = 0; t < nt; t += 2) {
            const bool last = (t == nt - 2);
            const char* a1 = cA + (size_t)(t + 1) * kstep;
            const char* a2 = last ? nA : cA + (size_t)(t + 2) * kstep; const char* b2 = last ? nB : cB + (size_t)(t + 2) * kstep;
            const char* a3 = a2 + kstep; const char* b3 = b2 + kstep;
            if constexpr (SP2) {
            PG8_LDB(B0, 0, 0); PG8_LDB(B1, 0, 1); PG8_SCHED; PG8_LDA(At, 0, 0); PG8_STAGE(PG8_SA(1, 1), a1 + hstep, voffA);
            PG8_WAIT_V(8); PG8_WAIT_L(0); PG8_BAR; PG8_MMA(0, 0, At, B0); PG8_MMA(0, 1, At, B1); PG8_BAR; PG8_SCHED;
            PG8_LDA(At, 0, 1); PG8_STAGE(PG8_SB(0, 0), b2, voffB); PG8_STAGE(PG8_SB(0, 1), b2 + hstep, voffB); PG8_STAGE(PG8_SA(0, 0), a2, voffA);
            PG8_WAIT_V(8); PG8_WAIT_L(0); PG8_BAR; PG8_MMA(1, 0, At, B0); PG8_MMA(1, 1, At, B1); PG8_BAR; PG8_SCHED;
            PG8_LDB(B0, 1, 0); PG8_LDB(B1, 1, 1); PG8_SCHED; PG8_LDA(At, 1, 0); PG8_STAGE(PG8_SA(0, 1), a2 + hstep, voffA);
            PG8_WAIT_V(8); PG8_WAIT_L(0); PG8_BAR; PG8_MMA(0, 0, At, B0); PG8_MMA(0, 1, At, B1); PG8_BAR; PG8_SCHED;
            PG8_LDA(At, 1, 1); PG8_STAGE(PG8_SB(1, 0), b3, voffB); PG8_STAGE(PG8_SB(1, 1), b3 + hstep, voffB); PG8_STAGE(PG8_SA(1, 0), a3, voffA);
            PG8_WAIT_V(8); PG8_WAIT_L(0); PG8_BAR; PG8_MMA(1, 0, At, B0); PG8_MMA(1, 1, At, B1); PG8_BAR; PG8_SCHED;
            } else {
            PG8_LDB(B0, 0, 0); PG8_SCHED; PG8_LDA(At, 0, 0); PG8_STAGE(PG8_SA(1, 1), a1 + hstep, voffA);
            PG8_WAIT_L(8); PG8_BAR; PG8_WAIT_L(0); PG8_MMA(0, 0, At, B0); PG8_BAR; PG8_SCHED;
            PG8_LDB(B1, 0, 1); PG8_STAGE(PG8_SB(0, 0), b2, voffB);
            PG8_BAR; PG8_WAIT_L(0); PG8_MMA(0, 1, At, B1); PG8_BAR;
            PG8_LDA(At, 0, 1); PG8_STAGE(PG8_SA(0, 0), a2, voffA);
            PG8_BAR; PG8_WAIT_L(0); PG8_MMA(1, 0, At, B0); PG8_BAR; PG8_SCHED;
            PG8_STAGE(PG8_SB(0, 1), b2 + hstep, voffB);
            PG8_WAIT_V(6); PG8_BAR; PG8_MMA(1, 1, At, B1); PG8_BAR;
            PG8_LDB(B0, 1, 0); PG8_SCHED; PG8_LDA(At, 1, 0); PG8_STAGE(PG8_SA(0, 1), a2 + hstep, voffA);
            PG8_WAIT_L(8); PG8_BAR; PG8_WAIT_L(0); PG8_MMA(0, 0, At, B0); PG8_BAR; PG8_SCHED;
            PG8_LDB(B1, 1, 1); PG8_STAGE(PG8_SB(1, 0), b3, voffB);
            PG8_BAR; PG8_WAIT_L(0); PG8_MMA(0, 1, At, B1); PG8_BAR;
            PG8_LDA(At, 1, 1); PG8_STAGE(PG8_SA(1, 0), a3, voffA);
            PG8_BAR; PG8_WAIT_L(0); PG8_MMA(1, 0, At, B0); PG8_BAR; PG8_SCHED;
            PG8_STAGE(PG8_SB(1, 1), b3 + hstep, voffB);
            PG8_WAIT_V(6); PG8_BAR; PG8_MMA(1, 1, At, B1); PG8_BAR;
            }
        }
        if constexpr (ALIGN_EPI) { if (wr == 0) PG8_BAR; }
        E(acc, cur, wr, wc, fr, fq);
        if (!has_next) break;
#pragma unroll
        for (int a = 0; a < 2; ++a)
#pragma unroll
            for (int b = 0; b < 2; ++b)
#pragma unroll
                for (int m = 0; m < 4; ++m)
#pragma unroll
                    for (int n = 0; n < 2; ++n) acc[a][b][m][n] = (f32x4){0.f, 0.f, 0.f, 0.f};
        cur = nxt; cA = nA; cB = nB; ++ui;
        if constexpr (ALIGN_EPI) { if (wr == 1) PG8_BAR; }
    }
    PG8_WAIT_V(0);
    if constexpr (!ALIGN_EPI) { if (wr == 0) PG8_BAR; }
    PG8_BAR;
#undef PG8_SA
#undef PG8_SB
#undef PG8_STAGE
#undef PG8_LDA
#undef PG8_LDB
#undef PG8_MMA
#undef PG8_WAIT_V
#undef PG8_WAIT_L
#undef PG8_BAR
#undef PG8_SCHED
}
template <int IMM> __device__ __forceinline__ void glds16s(const void* sbase, unsigned voff, unsigned lds_wave_base) { unsigned keep;
    asm volatile("s_mov_b32 %0, m0\n\ts_add_i32 m0, %3, %4\n\ts_nop 0\n\tglobal_load_lds_dwordx4 %1, %2\n\ts_mov_b32 m0, %0" : "=&s"(keep) : "v"(voff), "s"(sbase), "s"(lds_wave_base), "n"(IMM) : "memory", "scc"); }
typedef int i32x4 __attribute__((ext_vector_type(4))); typedef int i32x8 __attribute__((ext_vector_type(8)));
template <class Epi, class Sched, bool ALIGN_EPI = false, bool SP2 = false>
__device__ __forceinline__ void gemm_phase8(PG8_LAS unsigned char* lds, const Gemm g, const Sched& S, const Epi& E) {
    int tid_ = threadIdx.x; asm volatile("" : "+v"(tid_));
    const int tid = tid_, wid = __builtin_amdgcn_readfirstlane(tid >> 6), lane = tid & 63, wr = wid >> 2, wc = wid & 3, fr = lane & 15, fq = lane >> 4;
    const int K = g.K, nt = K / BK, LD = g.ld;
    unsigned voffA[2], voffB[2];
#pragma unroll
    for (int i = 0; i < 2; ++i) { int R, C; stage_rc(tid * 16 + i * 8192, R, C); const int Rb = Epi::PERM ? ((R & ~31) + perm32(R & 31)) : R;
        voffA[i] = (unsigned)(R * LD + C) * 2u; voffB[i] = (unsigned)(Rb * LD + C) * 2u; }
    const size_t kstep = (size_t)(BK * 2);
    const size_t hstep = (size_t)HALF * LD * 2;
    const size_t tstep = 2 * hstep;
    const unsigned ldsw = (unsigned)wid * 1024u; const unsigned ldswb = (unsigned)__builtin_amdgcn_readfirstlane((int)((unsigned)(size_t)lds + ldsw));
    const int aoff = lds_byte(wr * 64 + fr, fq * 8), boff = lds_byte(wc * 32 + fr, fq * 8);
#define PG8_SA(b, h) (((b) * 2 + (h)) * HTB)
#define PG8_SB(b, h) ((4 + (b) * 2 + (h)) * HTB)
#define PG8_STAGE(bufoff, gbase, voff) do { glds16s<(bufoff)>((const void*)(gbase), (voff)[0], ldswb); glds16s<(bufoff) + 8192>((const void*)(gbase), (voff)[1], ldswb); } while (0)
#define PG8_LDA(dst, b, h) do { _Pragma("unroll") for (int m = 0; m < 4; ++m) dst[m] = __builtin_shufflevector(*(const PG8_LAS i32x4*)(lds + PG8_SA(b, h) + aoff + m * 2048), *(const PG8_LAS i32x4*)(lds + PG8_SA(b, h) + aoff + m * 2048 + 1024), 0, 1, 2, 3, 4, 5, 6, 7); } while (0)
#define PG8_LDB(dst, b, h) do { _Pragma("unroll") for (int n = 0; n < 2; ++n) dst[n] = __builtin_shufflevector(*(const PG8_LAS i32x4*)(lds + PG8_SB(b, h) + boff + n * 2048), *(const PG8_LAS i32x4*)(lds + PG8_SB(b, h) + boff + n * 2048 + 1024), 0, 1, 2, 3, 4, 5, 6, 7); } while (0)
#define PG8_MMA(ai, bj, At, Bt) do { __builtin_amdgcn_s_setprio(1); _Pragma("unroll") for (int m = 0; m < 4; ++m) _Pragma("unroll") for (int n = 0; n < 2; ++n) \
        acc[ai][bj][m][n] = __builtin_amdgcn_mfma_scale_f32_16x16x128_f8f6f4(Bt[n], At[m], acc[ai][bj][m][n], 0, 0, 0, 0x7f7f7f7f, 0, 0x7f7f7f7f); __builtin_amdgcn_s_setprio(0); } while (0)
#define PG8_WAIT_V(n) asm volatile("s_waitcnt vmcnt(" #n ")" ::: "memory")
#define PG8_WAIT_L(n) asm volatile("s_waitcnt lgkmcnt(" #n ")" ::: "memory")
#define PG8_BAR __builtin_amdgcn_s_barrier()
#define PG8_SCHED __builtin_amdgcn_sched_barrier(0)
    Unit cur, nxt; int ui = 0;
    if (!S.next(0, cur)) return;
    f32x4 acc[2][2][4][2];
#pragma unroll
    for (int a = 0; a < 2; ++a)
#pragma unroll
        for (int b = 0; b < 2; ++b)
#pragma unroll
            for (int m = 0; m < 4; ++m)
#pragma unroll
                for (int n = 0; n < 2; ++n) acc[a][b][m][n] = (f32x4){0.f, 0.f, 0.f, 0.f};
    i32x8 At[4], B0[2], B1[2];
    const char* cA = (const char*)g.A + (size_t)cur.pm * tstep + (size_t)cur.ko * 2; const char* cB = (const char*)g.Bt + (size_t)cur.pb * tstep + (size_t)cur.ko * 2;
    if constexpr (SP2) {
        PG8_STAGE(PG8_SB(0, 0), cB, voffB); PG8_STAGE(PG8_SB(0, 1), cB + hstep, voffB); PG8_STAGE(PG8_SA(0, 0), cA, voffA); PG8_STAGE(PG8_SA(0, 1), cA + hstep, voffA);
        if (wr == 1) PG8_BAR;
        PG8_WAIT_V(2); PG8_BAR;
        PG8_STAGE(PG8_SB(1, 0), cB + kstep, voffB); PG8_STAGE(PG8_SA(1, 0), cA + kstep, voffA); PG8_STAGE(PG8_SB(1, 1), cB + hstep + kstep, voffB);
        PG8_WAIT_V(6); PG8_BAR;
    } else {
        PG8_STAGE(PG8_SB(0, 0), cB, voffB); PG8_STAGE(PG8_SA(0, 0), cA, voffA); PG8_STAGE(PG8_SB(0, 1), cB + hstep, voffB); PG8_STAGE(PG8_SA(0, 1), cA + hstep, voffA);
        if (wr == 1) PG8_BAR;
        PG8_WAIT_V(4); PG8_BAR;
        PG8_STAGE(PG8_SB(1, 0), cB + kstep, voffB); PG8_STAGE(PG8_SA(1, 0), cA + kstep, voffA); PG8_STAGE(PG8_SB(1, 1), cB + hstep + kstep, voffB);
        PG8_WAIT_V(6); PG8_BAR;
    }
    for (;;) {
        const bool has_next = S.next(ui + 1, nxt);
        const char* nA = has_next ? (const char*)g.A + (size_t)nxt.pm * tstep + (size_t)nxt.ko * 2 : cA; const char* nB = has_next ? (const char*)g.Bt + (size_t)nxt.pb * tstep + (size_t)nxt.ko * 2 : cB;
#pragma nounroll
        for (int t = 0; t < nt; t += 2) {
            const bool last = (t == nt - 2);
            const char* a1 = cA + (size_t)(t + 1) * kstep;
            const char* a2 = last ? nA : cA + (size_t)(t + 2) * kstep; const char* b2 = last ? nB : cB + (size_t)(t + 2) * kstep;
            const char* a3 = a2 + kstep; const char* b3 = b2 + kstep;
            if constexpr (SP2) {
            PG8_LDB(B0, 0, 0); PG8_LDB(B1, 0, 1); PG8_SCHED; PG8_LDA(At, 0, 0); PG8_STAGE(PG8_SA(1, 1), a1 + hstep, voffA);
            PG8_WAIT_V(8); PG8_WAIT_L(0); PG8_BAR; PG8_MMA(0, 0, At, B0); PG8_MMA(0, 1, At, B1); PG8_BAR; PG8_SCHED;
            PG8_LDA(At, 0, 1); PG8_STAGE(PG8_SB(0, 0), b2, voffB); PG8_STAGE(PG8_SB(0, 1), b2 + hstep, voffB); PG8_STAGE(PG8_SA(0, 0), a2, voffA);
            PG8_WAIT_V(8); PG8_WAIT_L(0); PG8_BAR; PG8_MMA(1, 0, At, B0); PG8_MMA(1, 1, At, B1); PG8_BAR; PG8_SCHED;
            PG8_LDB(B0, 1, 0); PG8_LDB(B1, 1, 1); PG8_SCHED; PG8_LDA(At, 1, 0); PG8_STAGE(PG8_SA(0, 1), a2 + hstep, voffA);
            PG8_WAIT_V(8); PG8_WAIT_L(0); PG8_BAR; PG8_MMA(0, 0, At, B0); PG8_MMA(0, 1, At, B1); PG8_BAR; PG8_SCHED;
            PG8_LDA(At, 1, 1); PG8_STAGE(PG8_SB(1, 0), b3, voffB); PG8_STAGE(PG8_SB(1, 1), b3 + hstep, voffB); PG8_STAGE(PG8_SA(1, 0), a3, voffA);
            PG8_WAIT_V(8); PG8_WAIT_L(0); PG8_BAR; PG8_MMA(1, 0, At, B0); PG8_MMA(1, 1, At, B1); PG8_BAR; PG8_SCHED;
            } else {
            PG8_LDB(B0, 0, 0); PG8_SCHED; PG8_LDA(At, 0, 0); PG8_STAGE(PG8_SA(1, 1), a1 + hstep, voffA);
            PG8_WAIT_L(8); PG8_BAR; PG8_WAIT_L(0); PG8_MMA(0, 0, At, B0); PG8_BAR; PG8_SCHED;
            PG8_LDB(B1, 0, 1); PG8_STAGE(PG8_SB(0, 0), b2, voffB);
            PG8_BAR; PG8_WAIT_L(0); PG8_MMA(0, 1, At, B1); PG8_BAR;
            PG8_LDA(At, 0, 1); PG8_STAGE(PG8_SA(0, 0), a2, voffA);
            PG8_BAR; PG8_WAIT_L(0); PG8_MMA(1, 0, At, B0); PG8_BAR; PG8_SCHED;
            PG8_STAGE(PG8_SB(0, 1), b2 + hstep, voffB);
            PG8_WAIT_V(6); PG8_BAR; PG8_MMA(1, 1, At, B1); PG8_BAR;
            PG8_LDB(B0, 1, 0); PG8_SCHED; PG8_LDA(At, 1, 0); PG8_STAGE(PG8_SA(0, 1), a2 + hstep, voffA);
            PG8_WAIT_L(8); PG8_BAR; PG8_WAIT_L(0); PG8_MMA(0, 0, At, B0); PG8_BAR; PG8_SCHED;
            PG8_LDB(B1, 1, 1); PG8_STAGE(PG8_SB(1, 0), b3, voffB);
            PG8_BAR; PG8_WAIT_L(0); PG8_MMA(0, 1, At, B1); PG8_BAR;
            PG8_LDA(At, 1, 1); PG8_STAGE(PG8_SA(1, 0), a3, voffA);
            PG8_BAR; PG8_WAIT_L(0); PG8_MMA(1, 0, At, B0); PG8_BAR; PG8_SCHED;
            PG8_STAGE(PG8_SB(1, 1), b3 + hstep, voffB);
            PG8_WAIT_V(6); PG8_BAR; PG8_MMA(1, 1, At, B1); PG8_BAR;
            }
        }
        if constexpr (ALIGN_EPI) { if (wr == 0) PG8_BAR; }
        { int l2_ = (int)threadIdx.x; asm volatile("" : "+v"(l2_)); E(acc, cur, wr, wc, l2_ & 15, (l2_ >> 4) & 3); }
        if (!has_next) break;
#pragma unroll
        for (int a = 0; a < 2; ++a)
#pragma unroll
            for (int b = 0; b < 2; ++b)
#pragma unroll
                for (int m = 0; m < 4; ++m)
#pragma unroll
                    for (int n = 0; n < 2; ++n) acc[a][b][m][n] = (f32x4){0.f, 0.f, 0.f, 0.f};
        cur = nxt; cA = nA; cB = nB; ++ui;
        if constexpr (ALIGN_EPI) { if (wr == 1) PG8_BAR; }
    }
    PG8_WAIT_V(0);
    if constexpr (!ALIGN_EPI) { if (wr == 0) PG8_BAR; }
    PG8_BAR;
#undef PG8_SA
#undef PG8_SB
#undef PG8_STAGE
#undef PG8_LDA
#undef PG8_LDB
#undef PG8_MMA
#undef PG8_WAIT_V
#undef PG8_WAIT_L
#undef PG8_BAR
#undef PG8_SCHED
}
}

#include <hip/hip_bf16.h>
#include <cmath>
namespace attn_body {
using bf16=__hip_bfloat16;
using bf16x8=__attribute__((ext_vector_type(8)))short;
using s16x4=__attribute__((ext_vector_type(4)))short;
using f32x16=__attribute__((ext_vector_type(16)))float;
using u32x4=__attribute__((ext_vector_type(4)))unsigned;
constexpr int SEQ=4096,D=64,DM=1024,ODM=2048;
constexpr int NW=8,QBLK=32,QB=QBLK*NW,KVBLK=64,NQB=SEQ/QB;
__device__ __forceinline__ int crow(int r,int hi){return (r&3)+8*(r>>2)+4*hi;}
#define SBAR() __builtin_amdgcn_sched_barrier(0)
__device__ __forceinline__ void cmask(f32x16&p0,f32x16&p1,int jb,int qrel,int hi){
  const float NEG=-INFINITY; int kb=64*jb+4*hi;
  #pragma unroll
  for(int r=0;r<16;++r){int kv=kb+(r&3)+8*(r>>2); if(kv>qrel)p0[r]=NEG; if(kv+32>qrel)p1[r]=NEG;}
}

constexpr int NSLOT=3, SLOTB=8192;
constexpr int LDS_K=0, LDS_V=NSLOT*SLOTB, LDS_WS=3*NSLOT*SLOTB, LDS_OST=LDS_WS+NW*64*4, LDS_BYTES=LDS_OST+NW*4096;
constexpr float C2=0.125f*1.4426950408889634f;
__device__ __forceinline__ void glds16(const void*gsrc,unsigned lds_dst){unsigned keep;
  asm volatile("s_mov_b32 %0, m0\n\ts_mov_b32 m0, %2\n\ts_nop 0\n\tglobal_load_lds_dwordx4 %1, off\n\ts_mov_b32 m0, %0":"=&s"(keep):"v"(gsrc),"s"(lds_dst):"memory");}
__device__ __forceinline__ float max3f(float a,float b,float c){float r;asm("v_max3_f32 %0, %1, %2, %3":"=v"(r):"v"(a),"v"(b),"v"(c));return r;}
__device__ __forceinline__ float max2f(float a,float b){float r;asm("v_max_f32_e32 %0, %1, %2":"=v"(r):"v"(a),"v"(b));return r;}
__device__ __forceinline__ float fadd_s(float a,float b){float r;asm("v_add_f32_e32 %0, %1, %2":"=v"(r):"v"(a),"v"(b));return r;}
__device__ __forceinline__ float fsub_s(float a,float b){float r;asm("v_sub_f32_e32 %0, %1, %2":"=v"(r):"v"(a),"v"(b));return r;}
typedef float f32x2_t __attribute__((ext_vector_type(2))); typedef __bf16 bf16x2_t __attribute__((ext_vector_type(2)));
__device__ __forceinline__ unsigned cvtpk_s(float lo,float hi){f32x2_t v={lo,hi};bf16x2_t b=__builtin_convertvector(v,bf16x2_t);return __builtin_bit_cast(unsigned,b);}
#define WAIT_BAR(N) asm volatile("s_waitcnt vmcnt(" #N ") lgkmcnt(0)\n\ts_barrier":::"memory")

__device__ __forceinline__ void qkt(f32x16&p0,f32x16&p1,const char*Kslot,__attribute__((address_space(3))) const char*qp,const f32x16&negm,int r32,int hi){
  const char*kb=Kslot+hi*1024+r32*16;
  #pragma unroll
  for(int d0=0;d0<4;++d0){
    const bf16x8 b0=*reinterpret_cast<const bf16x8*>(kb+d0*2048);
    const bf16x8 b1=*reinterpret_cast<const bf16x8*>(kb+d0*2048+512);
    const bf16x8 qf=*(const __attribute__((address_space(3))) bf16x8*)(qp+d0*1024);
    if(d0==0){p0=__builtin_amdgcn_mfma_f32_32x32x16_bf16(b0,qf,negm,0,0,0);p1=__builtin_amdgcn_mfma_f32_32x32x16_bf16(b1,qf,negm,0,0,0);}
    else{p0=__builtin_amdgcn_mfma_f32_32x32x16_bf16(b0,qf,p0,0,0,0);p1=__builtin_amdgcn_mfma_f32_32x32x16_bf16(b1,qf,p1,0,0,0);}}
}
typedef __attribute__((address_space(3))) const char* lds_cptr;
typedef short v4i16_t __attribute__((ext_vector_type(4)));
__device__ __forceinline__ void kload8(bf16x8*kf,lds_cptr kp){
  kf[0]=*(const __attribute__((address_space(3))) bf16x8*)(kp);      kf[1]=*(const __attribute__((address_space(3))) bf16x8*)(kp+512);
  kf[2]=*(const __attribute__((address_space(3))) bf16x8*)(kp+2048); kf[3]=*(const __attribute__((address_space(3))) bf16x8*)(kp+2560);
  kf[4]=*(const __attribute__((address_space(3))) bf16x8*)(kp+4096); kf[5]=*(const __attribute__((address_space(3))) bf16x8*)(kp+4608);
  kf[6]=*(const __attribute__((address_space(3))) bf16x8*)(kp+6144); kf[7]=*(const __attribute__((address_space(3))) bf16x8*)(kp+6656);
}
__device__ __forceinline__ void kload2(bf16x8*kf,lds_cptr kp,int j){ kf[2*j]=*(const __attribute__((address_space(3))) bf16x8*)(kp+j*2048); kf[2*j+1]=*(const __attribute__((address_space(3))) bf16x8*)(kp+j*2048+512); }
__device__ __forceinline__ s16x4 vtr(lds_cptr p){ return __builtin_bit_cast(s16x4,__builtin_amdgcn_ds_read_tr16_b64_v4i16((__attribute__((address_space(3))) v4i16_t*)p)); }
__device__ __forceinline__ float rowmax(const f32x16&p0,const f32x16&p1){
  float a=max3f(p0[0],p0[1],p1[0]),b=max3f(p0[2],p0[3],p1[1]);a=max3f(a,p1[2],p1[3]);
  #pragma unroll
  for(int r=4;r<16;r+=4){a=max3f(a,p0[r],p0[r+1]);b=max3f(b,p0[r+2],p0[r+3]);a=max3f(a,p1[r],p1[r+1]);b=max3f(b,p1[r+2],p1[r+3]);}
  const float m=max2f(a,b);
  auto rr=__builtin_amdgcn_permlane32_swap(__float_as_uint(m),__float_as_uint(m),false,false);
  return max2f(__uint_as_float(rr[0]),__uint_as_float(rr[1]));
}
__device__ __forceinline__ void pv(f32x16*o,int vb,bf16x8 pa0,bf16x8 pa1,bf16x8 pa2,bf16x8 pa3){
  #pragma unroll
  for(int d0=0;d0<2;++d0){s16x4 lo[4],hi[4];
    #pragma unroll
    for(int ks=0;ks<4;++ks){
      asm volatile("ds_read_b64_tr_b16 %0,%1 offset:%c2":"=&v"(lo[ks]):"v"(vb),"i"(d0*4096+ks*1024):"memory");
      asm volatile("ds_read_b64_tr_b16 %0,%1 offset:%c2":"=&v"(hi[ks]):"v"(vb),"i"(d0*4096+ks*1024+512):"memory");}
    asm volatile("s_waitcnt lgkmcnt(0)":::"memory");SBAR();
    #define PK(k) (bf16x8){lo[k][0],lo[k][1],lo[k][2],lo[k][3],hi[k][0],hi[k][1],hi[k][2],hi[k][3]}
    o[d0]=__builtin_amdgcn_mfma_f32_32x32x16_bf16(pa0,PK(0),o[d0],0,0,0);
    o[d0]=__builtin_amdgcn_mfma_f32_32x32x16_bf16(pa1,PK(1),o[d0],0,0,0);
    o[d0]=__builtin_amdgcn_mfma_f32_32x32x16_bf16(pa2,PK(2),o[d0],0,0,0);
    o[d0]=__builtin_amdgcn_mfma_f32_32x32x16_bf16(pa3,PK(3),o[d0],0,0,0);
    #undef PK
  }
}

#ifndef ATTN_STORE16
#define ATTN_STORE16(p,v) (*(u32x4*)(p)=(v))
#endif
template<int THRL> __device__ __forceinline__ void attn_unit(int qb,const bf16*Q,const bf16*__restrict__ K,const bf16*__restrict__ V,bf16*O,char*shm){
  const int tid=threadIdx.x,lane=tid&63,r32=lane&31,hi=lane>>5; const int wid=__builtin_amdgcn_readfirstlane(tid>>6);
  const int q0=qb*QB;
  const bf16*Qw=Q+(long)(q0+wid*QBLK)*DM;
  const bf16*Kh=K,*Vh=V;
  const unsigned lds0=(unsigned)(uintptr_t)shm;
  float*wsf=(float*)(shm+LDS_WS)+wid*64;
  const bf16*ksrc=Kh+(long)lane*DM+wid*8;
  const bf16*vsrc=Vh+(long)(16*(wid&3)+(lane>>2))*DM+(wid>>2)*32+(lane&3)*8;
  const unsigned kdst=lds0+LDS_K+wid*1024, vdst=lds0+LDS_V+wid*1024;
  #define DMA_K(t,slot) glds16(ksrc+(long)(t)*KVBLK*DM,(unsigned)__builtin_amdgcn_readfirstlane(kdst+(slot)))
  #define DMA_V(t,slot) do{ glds16(vsrc+(long)(t)*KVBLK*DM,(unsigned)__builtin_amdgcn_readfirstlane(vdst+2*(slot))); glds16(vsrc+(long)(t)*KVBLK*DM+64,(unsigned)__builtin_amdgcn_readfirstlane(vdst+2*(slot)+8192)); }while(0)
  const int vb0=(int)(lds0+LDS_V)+((lane>>4)&1)*32+(lane&3)*8+(4*hi+((lane&15)>>2))*64;
  const char*Kbase=shm+LDS_K; bf16x8 kf[8];
  const lds_cptr shm3=(lds_cptr)shm; const lds_cptr kp0=shm3+LDS_K+hi*1024+r32*16; const lds_cptr vp0=shm3+LDS_V+((lane>>4)&1)*32+(lane&3)*8+(4*hi+((lane&15)>>2))*64;
  const int NT=(q0+QB)/KVBLK;
  DMA_K(0,0);DMA_V(0,0);DMA_K(1,SLOTB);
  const lds_cptr qp0=(lds_cptr)shm+LDS_OST+wid*4096+(hi*32+r32)*16;
  { bf16x8 qr[4];
  #pragma unroll
  for(int d0=0;d0<4;++d0)qr[d0]=*reinterpret_cast<const bf16x8*>(&Qw[(long)r32*DM+d0*16+hi*8]);
  #pragma unroll
  for(int d0=0;d0<4;++d0)*(__attribute__((address_space(3))) bf16x8*)((__attribute__((address_space(3))) char*)qp0+d0*1024)=qr[d0]; }
  float mhat=0.f,l_reg=0.f;f32x16 o[4];o[0]=f32x16{};o[1]=f32x16{};o[2]=f32x16{};o[3]=f32x16{};f32x16 negm=f32x16{};asm volatile("":"+v"(negm));
  const int qrel=wid*QBLK+r32;
  #define CMASK(P0,P1,t) do{int jb_=(t)-(NT-4); if(jb_>=0)cmask(P0,P1,jb_,qrel,hi);}while(0)
  bool resc=false;
  #define START(P0,P1) do{ const float rm=rowmax(P0,P1); resc=false; \
    { const float dl=rm; mhat=fadd_s(mhat,dl); \
      _Pragma("unroll") for(int r=0;r<16;++r){P0[r]=fsub_s(P0[r],dl);P1[r]=fsub_s(P1[r],dl);} \
      _Pragma("unroll") for(int r=0;r<16;++r)negm[r]=-mhat; asm volatile("":"+v"(negm)); } \
    _Pragma("unroll") for(int r=0;r<16;++r)P0[r]=__builtin_amdgcn_exp2f(P0[r]); }while(0)
  #define RESC() do{ if(resc){ asm volatile("s_waitcnt lgkmcnt(0)":::"memory"); \
      _Pragma("unroll") for(int d_=0;d_<4;++d_) _Pragma("unroll") for(int r=0;r<16;++r)o[d_][r]*=wsf[crow(r,hi)]; } }while(0)
  f32x16 pA0,pA1,pB0,pB1;
  int sl_prev=0,sl_cur=0,sl_next=SLOTB;
  #define ROT() do{sl_prev=sl_cur;sl_cur=sl_next;sl_next=(sl_next==(NSLOT-1)*SLOTB)?0:sl_next+SLOTB;}while(0)
  DMA_K(2,2*SLOTB);
  WAIT_BAR(4);
  qkt(pA0,pA1,Kbase,qp0,negm,r32,hi);asm volatile("s_nop 15\n\ts_nop 7":"+v"(pA0),"+v"(pA1));CMASK(pA0,pA1,0);
  START(pA0,pA1);
  _Pragma("unroll") for(int r=0;r<16;++r)pA1[r]=__builtin_amdgcn_exp2f(pA1[r]);
  WAIT_BAR(0);
  DMA_K(3,0);DMA_V(1,SLOTB);
  ROT();
  kload8(kf,kp0+sl_cur);
  WAIT_BAR(3);
  s16x4 vlo[8],vhi[8]; u32x4 pw0,pw1,pw2,pw3;
  #define PKW(P,B) cvtpk_s(P[B],P[B+1])
  #define PAF(k) __builtin_bit_cast(bf16x8,pw##k)
  #define VFR(i) (bf16x8){vlo[i][0],vlo[i][1],vlo[i][2],vlo[i][3],vhi[i][0],vhi[i][1],vhi[i][2],vhi[i][3]}
  #define PIN(x) asm volatile("":"+v"(x))
  #define MX3(a,b,c) __builtin_fmaxf(__builtin_fmaxf((a),(b)),(c))
  #define GAPA(MF,A0,A1,A2,A3,W0,W1,PW) do{ MF; sacc+=A0; sacc+=A1; sacc+=A2; sacc+=A3; PIN(sacc); W0; W1; PIN(PW); SBAR(); }while(0)
  #define EX(v) __builtin_amdgcn_exp2f(v)
  #define GAPB(MF,X,B) do{ MF; X[B]=EX(X[B]); X[B+1]=EX(X[B+1]); PIN(X); SBAR(); }while(0)
  #define VRD(i) do{ vlo[i]=vtr(vp_+(((i)>>2)*4096+((i)&3)*1024)); vhi[i]=vtr(vp_+(((i)>>2)*4096+((i)&3)*1024+512)); }while(0)
  #define QF(d) (*(const __attribute__((address_space(3))) bf16x8*)(qp0+(d)*1024))
  #define VRD2(i) do{ vlo[i]=vtr(vp_+(8192+((i)>>2)*4096+((i)&3)*1024)); vhi[i]=vtr(vp_+(8192+((i)>>2)*4096+((i)&3)*1024+512)); }while(0)
  #define KRD(G,j) do{ if(G){ kload2(kf,kp0+sl_next,j); SBAR(); } }while(0)
  #define STEP(C0,C1,P0,P1,t,GK,GV,GL) do{ SBAR(); \
    const lds_cptr vp_=vp0+2*sl_prev; \
    VRD(0); const bf16x8 q1_=QF(1); SBAR(); float sacc=(P0[0]+P0[1]); \
    GAPA(C0=__builtin_amdgcn_mfma_f32_32x32x16_bf16(kf[0],qn_,negm,0,0,0), P0[2],P0[3],P0[4],P0[5],     pw0[0]=PKW(P0,0), pw0[1]=PKW(P0,2), pw0); \
    VRD(4); SBAR(); GAPA(C1=__builtin_amdgcn_mfma_f32_32x32x16_bf16(kf[1],qn_,negm,0,0,0), P0[6],P0[7],P0[8],P0[9],     pw0[2]=PKW(P0,4), pw0[3]=PKW(P0,6), pw0); \
    VRD(1); const bf16x8 q2_=QF(2); SBAR(); GAPA(C0=__builtin_amdgcn_mfma_f32_32x32x16_bf16(kf[2],q1_,C0,0,0,0),   P0[10],P0[11],P0[12],P0[13], pw1[0]=PKW(P0,8), pw1[1]=PKW(P0,10), pw1); \
    VRD(5); SBAR(); GAPA(C1=__builtin_amdgcn_mfma_f32_32x32x16_bf16(kf[3],q1_,C1,0,0,0),   P0[14],P0[15],P1[0],P1[1],   pw1[2]=PKW(P0,12),pw1[3]=PKW(P0,14), pw1); \
    VRD(2); const bf16x8 q3_=QF(3); SBAR(); GAPA(C0=__builtin_amdgcn_mfma_f32_32x32x16_bf16(kf[4],q2_,C0,0,0,0),   P1[2],P1[3],P1[4],P1[5],     pw2[0]=PKW(P1,0), pw2[1]=PKW(P1,2), pw2); \
    VRD(6); SBAR(); GAPA(C1=__builtin_amdgcn_mfma_f32_32x32x16_bf16(kf[5],q2_,C1,0,0,0),   P1[6],P1[7],P1[8],P1[9],     pw2[2]=PKW(P1,4), pw2[3]=PKW(P1,6), pw2); \
    VRD(3); SBAR(); GAPA(C0=__builtin_amdgcn_mfma_f32_32x32x16_bf16(kf[6],q3_,C0,0,0,0),   P1[10],P1[11],P1[12],P1[13], pw3[0]=PKW(P1,8), pw3[1]=PKW(P1,10), pw3); \
    VRD(7); SBAR(); GAPA(C1=__builtin_amdgcn_mfma_f32_32x32x16_bf16(kf[7],q3_,C1,0,0,0),   P1[14],P1[15],0.f,0.f,       pw3[2]=PKW(P1,12),pw3[3]=PKW(P1,14), pw3); \
    l_reg+=sacc; \
    if(GK){DMA_K((t)+3,sl_cur);} if(GV){DMA_V((t)+1,sl_next);} \
    CMASK(C0,C1,t); \
    { float a=MX3(C0[0],C0[1],C1[0]),b=MX3(C0[2],C0[3],C1[1]); a=MX3(a,C1[2],C1[3]); \
      _Pragma("unroll") for(int r=4;r<16;r+=4){a=MX3(a,C0[r],C0[r+1]);b=MX3(b,C0[r+2],C0[r+3]);a=MX3(a,C1[r],C1[r+1]);b=MX3(b,C1[r+2],C1[r+3]);} \
      float rm=__builtin_fmaxf(a,b); { auto rr=__builtin_amdgcn_permlane32_swap(__float_as_uint(rm),__float_as_uint(rm),false,false); rm=__builtin_fmaxf(__uint_as_float(rr[0]),__uint_as_float(rr[1])); } \
      resc=false; \
      if(__builtin_expect(__any(rm>(float)THRL),0)){ const float dl=__builtin_fmaxf(rm,0.f); mhat+=dl; \
        _Pragma("unroll") for(int r=0;r<16;++r){C0[r]-=dl;C1[r]-=dl;} \
        _Pragma("unroll") for(int r=0;r<16;++r)negm[r]=-mhat; asm volatile("":"+v"(negm)); \
        const float f=__builtin_amdgcn_exp2f(-dl); l_reg*=f; if(hi==0)wsf[r32]=f; resc=true; } } \
    SBAR(); \
    GAPB(o[0]=__builtin_amdgcn_mfma_f32_32x32x16_bf16(PAF(0),VFR(0),o[0],0,0,0), C0,0); \
    GAPB(o[1]=__builtin_amdgcn_mfma_f32_32x32x16_bf16(PAF(0),VFR(4),o[1],0,0,0), C0,2); \
    KRD(GL,0); GAPB(o[0]=__builtin_amdgcn_mfma_f32_32x32x16_bf16(PAF(1),VFR(1),o[0],0,0,0), C0,4); \
    KRD(GL,1); GAPB(o[1]=__builtin_amdgcn_mfma_f32_32x32x16_bf16(PAF(1),VFR(5),o[1],0,0,0), C0,6); \
    KRD(GL,2); GAPB(o[0]=__builtin_amdgcn_mfma_f32_32x32x16_bf16(PAF(2),VFR(2),o[0],0,0,0), C0,8); \
    KRD(GL,3); GAPB(o[1]=__builtin_amdgcn_mfma_f32_32x32x16_bf16(PAF(2),VFR(6),o[1],0,0,0), C0,10); \
    GAPB(o[0]=__builtin_amdgcn_mfma_f32_32x32x16_bf16(PAF(3),VFR(3),o[0],0,0,0), C0,12); \
    GAPB(o[1]=__builtin_amdgcn_mfma_f32_32x32x16_bf16(PAF(3),VFR(7),o[1],0,0,0), C0,14); \
      \
    VRD2(0); VRD2(4); SBAR(); \
    VRD2(1); VRD2(5); SBAR(); GAPB(o[2]=__builtin_amdgcn_mfma_f32_32x32x16_bf16(PAF(0),VFR(0),o[2],0,0,0), C1,0); GAPB(o[3]=__builtin_amdgcn_mfma_f32_32x32x16_bf16(PAF(0),VFR(4),o[3],0,0,0), C1,2); \
    VRD2(2); VRD2(6); SBAR(); GAPB(o[2]=__builtin_amdgcn_mfma_f32_32x32x16_bf16(PAF(1),VFR(1),o[2],0,0,0), C1,4); GAPB(o[3]=__builtin_amdgcn_mfma_f32_32x32x16_bf16(PAF(1),VFR(5),o[3],0,0,0), C1,6); \
    VRD2(3); VRD2(7); SBAR(); GAPB(o[2]=__builtin_amdgcn_mfma_f32_32x32x16_bf16(PAF(2),VFR(2),o[2],0,0,0), C1,8); GAPB(o[3]=__builtin_amdgcn_mfma_f32_32x32x16_bf16(PAF(2),VFR(6),o[3],0,0,0), C1,10); \
    qn_=QF(0); GAPB(o[2]=__builtin_amdgcn_mfma_f32_32x32x16_bf16(PAF(3),VFR(3),o[2],0,0,0), C1,12); GAPB(o[3]=__builtin_amdgcn_mfma_f32_32x32x16_bf16(PAF(3),VFR(7),o[3],0,0,0), C1,14); \
    }while(0)
  bf16x8 qn_=QF(0);
  int t=1;
  #undef CMASK
  #define CMASK(P0,P1,t) do{}while(0)
  for(;t+5<NT;t+=2){
    STEP(pB0,pB1,pA0,pA1,t,true,true,true);     WAIT_BAR(3); RESC(); ROT();
    STEP(pA0,pA1,pB0,pB1,t+1,true,true,true);   WAIT_BAR(3); RESC(); ROT();
  }
  #undef CMASK
  #define CMASK(P0,P1,t) do{int jb_=(t)-(NT-4); if(jb_>=0)cmask(P0,P1,jb_,qrel,hi);}while(0)
  #define ENDW(tt) do{ if((tt)+3<NT){WAIT_BAR(3);} else if((tt)+2<NT){WAIT_BAR(2);} else {WAIT_BAR(0);} }while(0)
  for(;t+1<NT;t+=2){
    STEP(pB0,pB1,pA0,pA1,t,(t+3<NT),(t+1<NT),(t+1<NT));       ENDW(t);   RESC(); ROT();
    STEP(pA0,pA1,pB0,pB1,t+1,(t+4<NT),(t+2<NT),(t+2<NT));     ENDW(t+1); RESC(); ROT();
  }
  STEP(pB0,pB1,pA0,pA1,NT-1,false,false,false); RESC();
  { float sacc=pB0[0]+pB0[1]; _Pragma("unroll") for(int r=2;r<16;++r)sacc+=pB0[r]; _Pragma("unroll") for(int r=0;r<16;++r)sacc+=pB1[r]; l_reg+=sacc;
    pw0=(u32x4){PKW(pB0,0),PKW(pB0,2),PKW(pB0,4),PKW(pB0,6)};pw1=(u32x4){PKW(pB0,8),PKW(pB0,10),PKW(pB0,12),PKW(pB0,14)};pw2=(u32x4){PKW(pB1,0),PKW(pB1,2),PKW(pB1,4),PKW(pB1,6)};pw3=(u32x4){PKW(pB1,8),PKW(pB1,10),PKW(pB1,12),PKW(pB1,14)};
    SBAR(); pv(o,vb0+2*sl_cur,PAF(0),PAF(1),PAF(2),PAF(3)); pv(o+2,vb0+2*sl_cur+8192,PAF(0),PAF(1),PAF(2),PAF(3)); }
  #undef PKW
  #undef PAF
  #undef VFR
  #undef PIN
  #undef MX3
  #undef GAPA
  #undef GAPB
  #undef EX
  #undef VRD
  #undef VRD2
  #undef QF
  #undef KRD
  #undef STEP
  #undef ENDW
  {auto rr=__builtin_amdgcn_permlane32_swap(__float_as_uint(l_reg),__float_as_uint(l_reg),false,false);l_reg=__uint_as_float(rr[0])+__uint_as_float(rr[1]);}
  if(hi==0)wsf[32+r32]=l_reg;asm volatile("s_waitcnt lgkmcnt(0)":::"memory");
  float rli[16];
  #pragma unroll
  for(int r=0;r<16;++r)rli[r]=__builtin_amdgcn_rcpf(wsf[32+crow(r,hi)]);
  bf16*Ow=O+(long)(q0+wid*QBLK)*ODM;
  { bf16*stg=(bf16*)(shm+LDS_OST)+wid*2048;
    #pragma unroll
    for(int hv=0;hv<2;++hv){
      #pragma unroll
      for(int r=0;r<16;++r){const int orow=crow(r,hi);
        #pragma unroll
        for(int d0=0;d0<2;++d0)stg[orow*64+d0*32+r32]=__float2bfloat16(o[2*hv+d0][r]*rli[r]);}
      asm volatile("s_waitcnt lgkmcnt(0)":::"memory");
      #pragma unroll
      for(int i=0;i<4;++i){const int row=i*8+(lane>>3),ch=lane&7; const u32x4 v=*(const u32x4*)(stg+row*64+ch*8); ATTN_STORE16(Ow+(long)row*ODM+hv*64+ch*8,v);}
      asm volatile("s_waitcnt lgkmcnt(0)":::"memory"); } }
  asm volatile("s_waitcnt lgkmcnt(0)\n\ts_barrier":::"memory");
  #undef DMA_K
  #undef DMA_V
  #undef CMASK
  #undef START
  #undef RESC
  #undef ROT
}
constexpr int ATTN_LDS_BYTES=LDS_BYTES;
struct AttnTensors { const bf16* Q; const bf16* K; const bf16* V; bf16* O; };
template<int THRL=8> __device__ __forceinline__ void attn_phase(char*lds,const AttnTensors&T,int vcu,int G){
  for(int i=0;;++i){
    int combo,qb;
    if(G==256){ if(i>=4)break; combo=vcu>>2; const int s_=vcu&3; qb=(i==0)?s_:(i==1)?15-s_:(i==2)?4+s_:11-s_; }
    else { const int idx=i*G+vcu; if(idx>=1024)break; combo=idx&63; qb=15-(idx>>6); }
    const int b=combo>>4, hc=combo&15;
    const long r0=(long)b*SEQ;
    attn_unit<THRL>(qb, T.Q+r0*DM+hc*64, T.K+r0*DM+hc*64, T.V+r0*DM+(hc>>1)*128, T.O+r0*ODM+hc*128, lds);
  }
}
#undef SBAR
#undef WAIT_BAR
}

#define GAS __attribute__((address_space(1)))
#define LAS __attribute__((address_space(3)))
typedef unsigned short bf16;
typedef unsigned v4u __attribute__((ext_vector_type(4)));
typedef float f32x4 __attribute__((ext_vector_type(4)));
typedef short bf16x8 __attribute__((ext_vector_type(8)));
typedef GAS unsigned gu32;
typedef GAS unsigned long long gu64;
#define RLX_AGENT __ATOMIC_RELAXED, __HIP_MEMORY_SCOPE_AGENT
#define LDS_WAIT() asm volatile("s_waitcnt lgkmcnt(0)" ::: "memory")
#define VM_WAIT() asm volatile("s_waitcnt vmcnt(0)" ::: "memory")
__device__ __forceinline__ unsigned long long rt() { return __builtin_amdgcn_s_memrealtime(); }
__device__ __forceinline__ unsigned f2bf(float f) { unsigned u = __builtin_bit_cast(unsigned, f); return (u + 0x7fffu + ((u >> 16) & 1u)) >> 16; }
__device__ __forceinline__ unsigned pk2(float lo, float hi) { return f2bf(lo) | (f2bf(hi) << 16); }

#define XB_TMO      128
#define XB_XCNT(j)  (256  + 64 * (j))
#define XB_XSUB(j)  (1280 + 64 * (j))
#define XB_XGEN(j)  (2304 + 64 * (j))
#define XB_TOP      3328
#define XB_TOPGEN   3392
#define XCD_BAR_WORDS 3456
#define XB_SPIN_CAP (1u << 18)

__device__ __forceinline__ unsigned xb_ld(unsigned* p)              { return __hip_atomic_load(p, __ATOMIC_RELAXED, __HIP_MEMORY_SCOPE_AGENT); }
__device__ __forceinline__ unsigned xb_add(unsigned* p, unsigned v) { return __hip_atomic_fetch_add(p, v, __ATOMIC_RELAXED, __HIP_MEMORY_SCOPE_AGENT); }
__device__ __forceinline__ unsigned xb_xcc_id() { return (unsigned)__builtin_amdgcn_s_getreg((3 << 11) | 20) & 0xFu; }
#define XB_SPIN(cond, bar) do { unsigned _sp = 0; while (cond) { __builtin_amdgcn_s_sleep(1); \
    if ((++_sp & 255u) == 0u) { if (xb_ld(&(bar)[XB_TMO])) break; if (_sp > XB_SPIN_CAP) { atomicAdd(&(bar)[XB_TMO], 1u); break; } } } } while (0)

struct XcdBarrier {
    unsigned* bar; unsigned x;
    volatile LAS unsigned* st;
};

__device__ __forceinline__ XcdBarrier xcd_barrier_post(unsigned* bar, volatile LAS unsigned* st) {
    XcdBarrier b; b.bar = bar; b.x = xb_xcc_id(); b.st = st;
    if (threadIdx.x == 0) (void)xb_add(&bar[XB_XCNT(b.x)], 1u);
    return b;
}
__device__ __forceinline__ void xcd_barrier_complete(unsigned* bar, unsigned x, unsigned& nloc, unsigned& nx) {
    const unsigned G = gridDim.x * gridDim.y * gridDim.z;
    unsigned sum, cnt, mine, sp = 0u;
    for (;;) {
        sum = 0u; cnt = 0u; mine = 0u;
#pragma unroll
        for (unsigned j = 0; j < 16; ++j) { const unsigned c = xb_ld(&bar[XB_XCNT(j)]); sum += c; cnt += (c > 0u) ? 1u : 0u; mine = (j == x) ? c : mine; }
        if (sum == G) break;
        __builtin_amdgcn_s_sleep(1);
        if ((++sp & 255u) == 0u) { if (xb_ld(&bar[XB_TMO])) break; if (sp > XB_SPIN_CAP) { atomicAdd(&bar[XB_TMO], 1u); break; } }
    }
    nloc = mine > 0u ? mine : 1u; nx = cnt > 0u ? cnt : 1u;
}

__device__ __forceinline__ void xcd_barrier(const XcdBarrier& b) {
    asm volatile("s_waitcnt vmcnt(0)" ::: "memory");
    __syncthreads();
    if (threadIdx.x == 0) {
        unsigned* bar = b.bar;
        __builtin_amdgcn_s_waitcnt(0);
        unsigned nloc = b.st[0], nx = b.st[1];
        if (nloc == 0u) { xcd_barrier_complete(bar, b.x, nloc, nx); b.st[0] = nloc; b.st[1] = nx; }
        const unsigned old = xb_add(&bar[XB_XSUB(b.x)], 1u);
        const unsigned gen = old / nloc;
        if (old + 1u == (gen + 1u) * nloc) {
            __builtin_amdgcn_fence(__ATOMIC_RELEASE, "agent");
            asm volatile("s_waitcnt vmcnt(0)" ::: "memory");
            const unsigned og = xb_add(&bar[XB_TOP], 1u);
            const unsigned tg = og / nx;
            if (og + 1u == (tg + 1u) * nx) xb_add(&bar[XB_TOPGEN], 1u);
            else XB_SPIN(xb_ld(&bar[XB_TOPGEN]) == tg, bar);
            __builtin_amdgcn_fence(__ATOMIC_ACQUIRE, "agent");
            xb_add(&bar[XB_XGEN(b.x)], 1u);
            asm volatile("s_waitcnt vmcnt(0)" ::: "memory");
        } else {
            XB_SPIN(xb_ld(&bar[XB_XGEN(b.x)]) == gen, bar);
            __builtin_amdgcn_fence(__ATOMIC_ACQUIRE, "agent");
            asm volatile("s_waitcnt vmcnt(0)" ::: "memory");
        }
    }
    __syncthreads();
}

constexpr int NWAVES = 8;
constexpr int T_ = 16384, SEQL = 4096, DMODEL = 2048, NINP = 10752, NIN_SRC = 10688;
constexpr int RWW = 3584;
constexpr int NEXP = 32, DEXP = 1024, MAXROWS = 40960, MAXTILES = 160;
constexpr size_t MiB = 1u << 20;
constexpr size_t WS_CTL = 0, CTL_ZERO_BYTES = 1 * MiB;
constexpr size_t WS_ROPE = 1 * MiB;
constexpr size_t WS_BON = 2 * MiB;
constexpr size_t WS_ASG_E = 3 * MiB, WS_ASG_POS = WS_ASG_E + 256 * 1024, WS_ASG_GATE = WS_ASG_POS + 256 * 1024, WS_TOKDEST = WS_ASG_GATE + 256 * 1024;
constexpr size_t WS_ROWGATE = 4 * MiB;
constexpr size_t WS_CNTT = 5 * MiB;
constexpr size_t WS_RSTD = 5 * MiB + 64 * 1024;
constexpr size_t WS_DELTA = 480 * MiB;
constexpr size_t WS_WIN = 16 * MiB;
constexpr size_t WS_WPA = 58 * MiB, WS_WPB = 62 * MiB, WS_WOUT = 66 * MiB;
constexpr size_t WS_WLORA = 74 * MiB;
constexpr size_t WS_WRT = 76 * MiB;
constexpr size_t WS_H = 80 * MiB;
constexpr size_t WS_Q = 144 * MiB, WS_K = 176 * MiB, WS_V = 208 * MiB, WS_G = 240 * MiB, WS_RW = 368 * MiB;
constexpr size_t WS_RS = 480 * MiB, WS_KS = 512 * MiB, WS_VS = 544 * MiB, WS_LA = 576 * MiB, WS_LD = 600 * MiB, WS_AS = 664 * MiB, WS_GG = 696 * MiB, WS_Y = 728 * MiB;
constexpr size_t WS_O = 368 * MiB;
constexpr size_t WS_YA = 144 * MiB, WS_YB = 176 * MiB;
constexpr size_t WS_TMP = 480 * MiB;
constexpr size_t WS_MERGED = 600 * MiB;
constexpr size_t WS_H8 = 792 * MiB, WS_WIN8 = 824 * MiB;
constexpr size_t WS_WGU = 792 * MiB, WS_WD = 920 * MiB;
constexpr size_t WS_LOGIT = 432 * MiB;
constexpr size_t WS_XG = 144 * MiB, WS_ACT = 224 * MiB, WS_YD = 272 * MiB, WS_END = 984 * MiB;
constexpr int CW_CNT = 64;
constexpr int CW_BAR = 4096;
constexpr int RING_OFF = 0, RING_BYTES = 131072;
constexpr int LDSCTL_OFF = RING_BYTES, MISC_OFF = LDSCTL_OFF + 320;
constexpr int TT_OFF = LDSCTL_OFF + 1024;
constexpr int LDS_BYTES = 147456;

typedef unsigned short bfu;
typedef unsigned u32x2 __attribute__((ext_vector_type(2)));
typedef float f32x2 __attribute__((ext_vector_type(2)));

__device__ __forceinline__ float wave_sum(float v) {
#pragma unroll
    for (int o = 1; o < 64; o <<= 1) v += __shfl_xor(v, o);
    return v;
}
__device__ __forceinline__ float bfl(unsigned w) { return __uint_as_float(w << 16); }
__device__ __forceinline__ float bfh(unsigned w) { return __uint_as_float(w & 0xffff0000u); }
__device__ __forceinline__ float sigm(float x) { return 1.0f / (1.0f + __expf(-x)); }
__device__ __forceinline__ void unpack16(const v4u a, const v4u b, float (&x)[16]) {
    x[0] = bfl(a.x); x[1] = bfh(a.x); x[2] = bfl(a.y); x[3] = bfh(a.y); x[4] = bfl(a.z); x[5] = bfh(a.z); x[6] = bfl(a.w); x[7] = bfh(a.w);
    x[8] = bfl(b.x); x[9] = bfh(b.x); x[10] = bfl(b.y); x[11] = bfh(b.y); x[12] = bfl(b.z); x[13] = bfh(b.z); x[14] = bfl(b.w); x[15] = bfh(b.w);
}
__device__ __forceinline__ void pack16(const float (&x)[16], v4u& a, v4u& b) {
    a.x = pk2(x[0], x[1]); a.y = pk2(x[2], x[3]); a.z = pk2(x[4], x[5]); a.w = pk2(x[6], x[7]);
    b.x = pk2(x[8], x[9]); b.y = pk2(x[10], x[11]); b.z = pk2(x[12], x[13]); b.w = pk2(x[14], x[15]);
}
__device__ __forceinline__ float dpp_f(float v, int ctrl_sel) {
    const int x = __builtin_bit_cast(int, v); int r;
    if (ctrl_sel == 0) r = __builtin_amdgcn_update_dpp(0, x, 0xB1, 0xF, 0xF, true);
    else if (ctrl_sel == 1) r = __builtin_amdgcn_update_dpp(0, x, 0x4E, 0xF, 0xF, true);
    else if (ctrl_sel == 2) r = __builtin_amdgcn_update_dpp(0, x, 0x141, 0xF, 0xF, true);
    else r = __builtin_amdgcn_update_dpp(0, x, 0x140, 0xF, 0xF, true);
    return __builtin_bit_cast(float, r);
}
__device__ __forceinline__ float row16_sum(float v) { v += dpp_f(v, 0); v += dpp_f(v, 1); v += dpp_f(v, 2); v += dpp_f(v, 3); return v; }
__device__ __forceinline__ float oct_sum(float v) { v += dpp_f(v, 0); v += dpp_f(v, 1); v += dpp_f(v, 2); return v; }
__device__ __forceinline__ float quad_sum(float v) { v += dpp_f(v, 0); v += dpp_f(v, 1); return v; }

__device__ __forceinline__ void transpose_item(const float* W, int ldw, int k0, int n0, bfu* WT, int ldk, size_t drow0, LAS float* scr, int lane) {
#pragma unroll 8
    for (int i = 0; i < 32; ++i) { const int kk = 2 * i + (lane >> 5); scr[kk * 33 + (lane & 31)] = W[(size_t)(k0 + kk) * ldw + n0 + (lane & 31)]; }
    LDS_WAIT(); asm volatile("" ::: "memory");
    const int c = lane & 7;
#pragma unroll
    for (int j = 0; j < 4; ++j) { const int n = (lane >> 3) + 8 * j; const LAS float* s = scr + (8 * c) * 33 + n;
        v4u o; o.x = pk2(s[0 * 33], s[1 * 33]); o.y = pk2(s[2 * 33], s[3 * 33]); o.z = pk2(s[4 * 33], s[5 * 33]); o.w = pk2(s[6 * 33], s[7 * 33]);
        *(GAS v4u*)(WT + (drow0 + n) * ldk + k0 + 8 * c) = o; }
    LDS_WAIT(); asm volatile("" ::: "memory");
}

__device__ __forceinline__ unsigned pk4f8(float a, float b, float c, float d) { int w = 0; w = __builtin_amdgcn_cvt_pk_fp8_f32(a, b, w, false); w = __builtin_amdgcn_cvt_pk_fp8_f32(c, d, w, true); return (unsigned)w; }
__device__ __forceinline__ unsigned pk4f8c(float a, float b, float c, float d) { return pk4f8(__builtin_amdgcn_fmed3f(a, -448.f, 448.f), __builtin_amdgcn_fmed3f(b, -448.f, 448.f), __builtin_amdgcn_fmed3f(c, -448.f, 448.f), __builtin_amdgcn_fmed3f(d, -448.f, 448.f)); }
__device__ __forceinline__ void transpose_item8(const float* W, int ldw, int k0, int n0, unsigned char* WT, int ldk, size_t drow0, float sc, LAS float* scr, int lane) {
#pragma unroll 8
    for (int i = 0; i < 32; ++i) { const int kk = 2 * i + (lane >> 5); scr[kk * 33 + (lane & 31)] = W[(size_t)(k0 + kk) * ldw + n0 + (lane & 31)]; }
    LDS_WAIT(); asm volatile("" ::: "memory");
    const int c = lane & 3;
#pragma unroll
    for (int j = 0; j < 2; ++j) { const int n = (lane >> 2) + 16 * j; const LAS float* s = scr + (16 * c) * 33 + n;
        v4u o; o.x = pk4f8(s[0 * 33] * sc, s[1 * 33] * sc, s[2 * 33] * sc, s[3 * 33] * sc); o.y = pk4f8(s[4 * 33] * sc, s[5 * 33] * sc, s[6 * 33] * sc, s[7 * 33] * sc);
        o.z = pk4f8(s[8 * 33] * sc, s[9 * 33] * sc, s[10 * 33] * sc, s[11 * 33] * sc); o.w = pk4f8(s[12 * 33] * sc, s[13 * 33] * sc, s[14 * 33] * sc, s[15 * 33] * sc);
        *(GAS v4u*)(WT + (drow0 + n) * ldk + k0 + 16 * c) = o; }
    LDS_WAIT(); asm volatile("" ::: "memory");
}
constexpr float SA_H = 16.f, SB_W = 256.f, SA_ACT = 8.f, SA_M = 32.f;
template <bool F8> __device__ __forceinline__ void rms_row_to_bf16(const float* xrow, const float* g, bfu* orow, unsigned char* o8row, int lane, float eps) {
    const GAS f32x4* xr = (const GAS f32x4*)xrow + lane; const GAS f32x4* gr = (const GAS f32x4*)g + lane;
    f32x4 v[8]; float s = 0.f;
#pragma unroll
    for (int j = 0; j < 8; ++j) { v[j] = xr[64 * j]; s += (v[j].x * v[j].x + v[j].y * v[j].y) + (v[j].z * v[j].z + v[j].w * v[j].w); }
    const float rstd = 1.0f / sqrtf(wave_sum(s) * (1.f / 2048.f) + eps);
    GAS unsigned long long* o8 = (GAS unsigned long long*)orow + lane;
#pragma unroll
    for (int j = 0; j < 8; ++j) { const f32x4 gg = gr[64 * j]; const float a0 = v[j].x * rstd * gg.x, a1 = v[j].y * rstd * gg.y, a2 = v[j].z * rstd * gg.z, a3 = v[j].w * rstd * gg.w;
        o8[64 * j] = (unsigned long long)pk2(a0, a1) | ((unsigned long long)pk2(a2, a3) << 32);
        if (F8) ((GAS unsigned*)o8row)[lane + 64 * j] = pk4f8c(a0 * SA_H, a1 * SA_H, a2 * SA_H, a3 * SA_H); }
}
typedef const __attribute__((address_space(4))) unsigned char* kaptr_t;
#define PH_BEGIN() kaptr_t ka_ = (kaptr_t)__builtin_amdgcn_kernarg_segment_ptr(); asm volatile("" : "+s"(ka_)); unsigned char* const ws = *(unsigned char* const __attribute__((address_space(4)))*)(ka_ + 264); (void)ws; int lane = (int)threadIdx.x; asm volatile("" : "+v"(lane)); lane &= 63
#define INP(k) (*(const float* const __attribute__((address_space(4)))*)(ka_ + 8 * (k)))
#define OUTP (*(float* const __attribute__((address_space(4)))*)(ka_ + 256))
#define ctl ((gu32*)(ws + WS_CTL))
#define Hb ((bfu*)(ws + WS_H))
#define Qb ((bfu*)(ws + WS_Q))
#define Kb ((bfu*)(ws + WS_K))
#define Vb ((bfu*)(ws + WS_V))
#define Gb ((bfu*)(ws + WS_G))
#define RWb ((bfu*)(ws + WS_RW))
#define RSb ((bfu*)(ws + WS_RS))
#define KSb ((bfu*)(ws + WS_KS))
#define VSb ((bfu*)(ws + WS_VS))
#define LAb ((bfu*)(ws + WS_LA))
#define LDf ((float*)(ws + WS_LD))
#define ASb ((bfu*)(ws + WS_AS))
#define GGb ((bfu*)(ws + WS_GG))
#define Yf ((float*)(ws + WS_Y))
#define Ob ((bfu*)(ws + WS_O))
#define YAb ((bfu*)(ws + WS_YA))
#define YBb ((bfu*)(ws + WS_YB))
#define TMPb ((bfu*)(ws + WS_TMP))
#define MRGb ((bfu*)(ws + WS_MERGED))
#define WINt ((bfu*)(ws + WS_WIN))
#define WPAt ((bfu*)(ws + WS_WPA))
#define WPBt ((bfu*)(ws + WS_WPB))
#define WOUTt ((bfu*)(ws + WS_WOUT))
#define WLORAt ((bfu*)(ws + WS_WLORA))
#define WRTt ((bfu*)(ws + WS_WRT))
#define H8p ((unsigned char*)(ws + WS_H8))
#define WIN8p ((unsigned char*)(ws + WS_WIN8))
#define WGUt ((bfu*)(ws + WS_WGU))
#define WDt ((bfu*)(ws + WS_WD))
#define ROPE ((float*)(ws + WS_ROPE))
#define BON ((float*)(ws + WS_BON))
#define ASG_E ((int*)(ws + WS_ASG_E))
#define ASG_POS ((int*)(ws + WS_ASG_POS))
#define ASG_GATE ((float*)(ws + WS_ASG_GATE))
#define TOKDEST ((int*)(ws + WS_TOKDEST))
#define ROWGATE ((float*)(ws + WS_ROWGATE))
#define CNTT ((int*)(ws + WS_CNTT))
#define RSTD ((float*)(ws + WS_RSTD))
#define DELTAb ((bfu*)(ws + WS_DELTA))
#define LOGIT ((float*)(ws + WS_LOGIT))
#define XGb ((bfu*)(ws + WS_XG))
#define ACTb ((bfu*)(ws + WS_ACT))
#define YDb ((bfu*)(ws + WS_YD))
static_assert(sizeof(void*) == 8, "kernarg offsets");

#ifndef DBG_BONV
#define DBG_BONV bs
#endif
struct Args { const float* in[32]; float* out; unsigned char* ws; int ph_lo, ph_hi, li, pad; };

__global__ void __launch_bounds__(NWAVES * 64, 2) mk_fwd(Args args) {
    extern __shared__ __attribute__((aligned(16))) unsigned char lds[];
    LAS unsigned char* L = (LAS unsigned char*)lds;
    volatile LAS unsigned* MISC = (volatile LAS unsigned*)(L + MISC_OFF);
    const int tid = threadIdx.x, wave = __builtin_amdgcn_readfirstlane(tid >> 6);
    const int G = gridDim.x; const int bx = blockIdx.x; const int vcu = (G % 8 == 0) ? (bx % 8) * (G / 8) + bx / 8 : bx;
    const int gw = vcu * NWAVES + wave, NGW = G * NWAVES;
    for (int u = tid; u < (LDS_BYTES - LDSCTL_OFF) / 4; u += NWAVES * 64) ((LAS unsigned*)(L + LDSCTL_OFF))[u] = 0u;
    __syncthreads();
    XcdBarrier bar; { unsigned char* const ws = args.ws; unsigned* const bw = (unsigned*)(ctl + CW_BAR) + args.li * XCD_BAR_WORDS; bar.bar = bw; bar.x = 0; bar.st = nullptr;
    if (!MK_SPLIT) bar = xcd_barrier_post(bw, MISC + 8); }
    const int lo = args.ph_lo, hi = args.ph_hi;
#ifdef PH_ONLY
#define IN(k) ((k) == PH_ONLY && lo <= (k) && (k) < hi)
#else
#define IN(k) (lo <= (k) && (k) < hi)
#endif
#define SEAM() do { if (!MK_SPLIT) xcd_barrier(bar); } while (0)

    if (IN(0)) { PH_BEGIN();
        LAS float* scr = (LAS float*)(L + RING_OFF + wave * 16384);
        {
            const float* W = INP(2); constexpr int NB = NIN_SRC / 32, NIT = 32 * NB;
            for (int it = gw; it < NIT; it += NGW) { const int kb = it / NB, nb = it % NB, n0 = 32 * nb; const int drow = n0 + (n0 >= 6592 ? 64 : 0), tile = drow >> 8;
                if ((tile >= 8 && tile < 12) || tile >= 26) transpose_item8(W, NIN_SRC, 64 * kb, n0, WIN8p, 2048, (size_t)drow, SB_W, scr, lane);
                else transpose_item(W, NIN_SRC, 64 * kb, n0, WINt, 2048, (size_t)drow, scr, lane); }
            for (int i = gw * 64 + lane; i < 64 * 2048 / 8; i += NGW * 64) *(GAS v4u*)(WINt + (size_t)6592 * 2048 + (size_t)i * 8) = (v4u){0u, 0u, 0u, 0u};
        }
        { const float* W = INP(21); for (int it = gw; it < 16 * 64; it += NGW) { const int kb = it / 64, nb = it % 64; transpose_item(W, 2048, 64 * kb, 32 * nb, WPAt, 1024, (size_t)(32 * nb), scr, lane); } }
        { const float* W = INP(22); for (int it = gw; it < 16 * 64; it += NGW) { const int kb = it / 64, nb = it % 64; transpose_item(W, 2048, 64 * kb, 32 * nb, WPBt, 1024, (size_t)(32 * nb), scr, lane); } }
        { const float* W = INP(23); for (int it = gw; it < 32 * 64; it += NGW) { const int kb = it / 64, nb = it % 64;
            if (WOUT_F8) transpose_item8(W, 2048, 64 * kb, 32 * nb, (unsigned char*)WOUTt, 2048, (size_t)(32 * nb), SB_W, scr, lane); else transpose_item(W, 2048, 64 * kb, 32 * nb, WOUTt, 2048, (size_t)(32 * nb), scr, lane); } }
        {
            const float* wu = INP(12); const float* au = INP(14); const float* gu = INP(15);
            for (int it = gw * 64 + lane; it < 3 * 32 * 1024; it += NGW * 64) { const int n = it & 1023, kg = (it >> 10) & 31, which = it >> 15; const float* src = which == 0 ? wu : (which == 1 ? au : gu); const int kmax = which == 2 ? 256 : 96;
                float v[8];
#pragma unroll
                for (int j = 0; j < 8; ++j) { const int k = kg * 8 + j; v[j] = k < kmax ? src[(size_t)k * 1024 + n] : 0.f; }
                v4u o; o.x = pk2(v[0], v[1]); o.y = pk2(v[2], v[3]); o.z = pk2(v[4], v[5]); o.w = pk2(v[6], v[7]);
                *(GAS v4u*)(WLORAt + ((size_t)(which * 1024 + n) * 256 + kg * 8)) = o; }
        }
        {
            const float* rg = INP(25); const float* re = INP(27); const float* g2w = INP(24);
            for (int it = gw * 64 + lane; it < 256 * 256; it += NGW * 64) { const int n = it & 255, kg = it >> 8; float v[8];
#pragma unroll
                for (int j = 0; j < 8; ++j) { const int k = kg * 8 + j; v[j] = (n < 4 ? rg[k * 4 + n] : (n < 36 ? re[k * 32 + (n - 4)] : 0.f)) * g2w[k]; }
                v4u o; o.x = pk2(v[0], v[1]); o.y = pk2(v[2], v[3]); o.z = pk2(v[4], v[5]); o.w = pk2(v[6], v[7]);
                *(GAS v4u*)(WRTt + ((size_t)n * 2048 + kg * 8)) = o; }
        }
#ifdef DBG_ZERO_AS
        for (size_t i = (size_t)gw * 64 + lane; i < (size_t)T_ * 1024 / 8; i += (size_t)NGW * 64) *(GAS v4u*)(ASb + i * 8) = (v4u){0u, 0u, 0u, 0u};
#endif
        for (int it = gw * 64 + lane; it < 4096 * 8; it += NGW * 64) { const int pos = it >> 3, i = it & 7; const float inv = exp2f(-(float)i * 0.125f * 18.931568569324174f);
            const float ang = (float)pos * inv; const float n = rintf(ang * 0.15915494309189535f); float r = fmaf(-n, 6.28125f, ang); r = fmaf(-n, 0.0019353071795864769f, r);
            ROPE[it] = __cosf(r); ROPE[4096 * 8 + it] = __sinf(r); }
        for (int m = gw; m < T_; m += NGW) rms_row_to_bf16<true>(INP(0) + (size_t)m * 2048, INP(1), Hb + (size_t)m * 2048, H8p + (size_t)m * 2048, lane, 1e-6f);
        SEAM();
    }

    if (IN(1)) { PH_BEGIN();
        const bool f8first = (G == 256 && (bx & 7) >= 4);
        if (f8first) { pg8::Gemm g{(const bfu*)H8p, (const bfu*)WIN8p, 1024, 1024}; pg8::WinOrder S; S.so.init(T_, 20 * 256, G, bx); S.f8 = 1;
          pg8::EpiWin E{Qb, Kb, Vb, RWb, Gb, 1.0f / (SA_H * SB_W)};
          pg8::gemm_phase8<pg8::EpiWin, pg8::WinOrder, true, true>(L + RING_OFF, g, S, E); }
        { pg8::Gemm g{Hb, WINt, 2048, 2048}; pg8::WinOrder S; S.so.init(T_, 22 * 256, G, bx); S.f8 = 0;
          pg8::EpiWin E{Qb, Kb, Vb, RWb, Gb, 1.0f};
          pg8::gemm_phase<pg8::EpiWin, pg8::WinOrder, true, true>(L + RING_OFF, g, S, E); }
        if (!f8first) { pg8::Gemm g{(const bfu*)H8p, (const bfu*)WIN8p, 1024, 1024}; pg8::WinOrder S; S.so.init(T_, 20 * 256, G, bx); S.f8 = 1;
          pg8::EpiWin E{Qb, Kb, Vb, RWb, Gb, 1.0f / (SA_H * SB_W)};
          pg8::gemm_phase8<pg8::EpiWin, pg8::WinOrder, true, true>(L + RING_OFF, g, S, E); }
        SEAM();
    }

    if (IN(2)) { PH_BEGIN();
        const float* qg = INP(3); const float* kg = INP(4); const float* mu = INP(10);
        const int quarter = lane & 3;
        float gq[16], gk[16], mur[16], muk[16], muv[16], mul[7];
#pragma unroll
        for (int i = 0; i < 16; ++i) { gq[i] = qg[16 * quarter + i]; gk[i] = kg[16 * quarter + i]; mur[i] = mu[16 * lane + i]; muk[i] = mu[1024 + 16 * lane + i]; muv[i] = mu[2048 + 16 * lane + i]; }
#pragma unroll
        for (int i = 0; i < 7; ++i) mul[i] = mu[3072 + lane + 64 * i];
        const float QSC = 0.125f * 1.4426950408889634f;
        for (int m = gw; m < T_; m += NGW) {
            const int pos = m & (SEQL - 1);
            float cs[8], sn[8];
            if (quarter == 0) {
#pragma unroll
                for (int i = 0; i < 8; ++i) { cs[i] = ROPE[pos * 8 + i]; sn[i] = ROPE[4096 * 8 + pos * 8 + i]; }
            }
#pragma unroll
            for (int qk = 0; qk < 2; ++qk) {
                bfu* p = (qk == 0 ? Qb : Kb) + (size_t)m * 1024 + 16 * lane;
                const v4u a = *(const GAS v4u*)p, b = *(const GAS v4u*)(p + 8);
                float xv[16]; unpack16(a, b, xv);
                float ss = 0.f;
#pragma unroll
                for (int i = 0; i < 16; ++i) ss += xv[i] * xv[i];
                ss = quad_sum(ss);
                const float rstd = 1.0f / sqrtf(ss * (1.f / 64.f) + 1e-6f);
#pragma unroll
                for (int i = 0; i < 16; ++i) xv[i] = xv[i] * rstd * (qk == 0 ? gq[i] : gk[i]);
                if (quarter == 0) {
#pragma unroll
                    for (int i = 0; i < 8; ++i) { const float x1 = xv[i], x2 = xv[8 + i]; xv[i] = x1 * cs[i] - x2 * sn[i]; xv[8 + i] = x2 * cs[i] + x1 * sn[i]; }
                }
                if (qk == 0) {
#pragma unroll
                    for (int i = 0; i < 16; ++i) xv[i] *= QSC;
                }
                v4u oa, ob; pack16(xv, oa, ob);
                *(GAS v4u*)p = oa; *(GAS v4u*)(p + 8) = ob;
            }
            const bool has_prev = pos != 0;
            const bfu* cur = RWb + (size_t)m * RWW; const bfu* prv = cur - RWW;
#pragma unroll
            for (int seg = 0; seg < 3; ++seg) {
                const bfu* pc = cur + seg * 1024 + 16 * lane; const bfu* pp = prv + seg * 1024 + 16 * lane;
                const v4u a = *(const GAS v4u*)pc, b = *(const GAS v4u*)(pc + 8);
                v4u c = (v4u){0u, 0u, 0u, 0u}, d = c;
                if (has_prev) { c = *(const GAS v4u*)pp; d = *(const GAS v4u*)(pp + 8); }
                float xc[16], xp[16]; unpack16(a, b, xc); unpack16(c, d, xp);
#pragma unroll
                for (int i = 0; i < 16; ++i) { const float mm = seg == 0 ? mur[i] : (seg == 1 ? muk[i] : muv[i]); xc[i] = xc[i] + (xp[i] - xc[i]) * mm; }
                v4u oa, ob; pack16(xc, oa, ob);
                bfu* po = (seg == 0 ? RSb : (seg == 1 ? KSb : VSb)) + (size_t)m * 1024 + 16 * lane;
                *(GAS v4u*)po = oa; *(GAS v4u*)(po + 8) = ob;
            }
            bfu* law = LAb + (size_t)m * 256; bfu* laa = LAb + (size_t)(T_ + m) * 256; bfu* lag = LAb + (size_t)(2 * T_ + m) * 256;
#pragma unroll
            for (int i = 0; i < 7; ++i) {
                const int c = lane + 64 * i;
                const float xc = bfl((unsigned)cur[3072 + c]); const float xp = has_prev ? bfl((unsigned)prv[3072 + c]) : 0.f;
                const float z = xc + (xp - xc) * mul[i];
                if (c < 96) { const float e2 = __expf(2.f * z); law[c] = (bfu)f2bf(1.0f - 2.0f / (e2 + 1.0f)); }
                else if (c < 192) laa[c - 96] = (bfu)f2bf(z);
                else lag[c - 192] = (bfu)f2bf(sigm(z));
            }
            for (int c = 96 + lane; c < 256; c += 64) { law[c] = 0; laa[c] = 0; }
        }
        SEAM();
    }

    if (IN(3)) { PH_BEGIN();
        const attn_body::AttnTensors AT{(const attn_body::bf16*)Qb, (const attn_body::bf16*)Kb, (const attn_body::bf16*)Vb, (attn_body::bf16*)Ob};
        attn_body::attn_phase<8>((char*)lds + RING_OFF, AT, vcu, G);
    }

    if (IN(4)) { PH_BEGIN();
        pg8::Gemm g{LAb, WLORAt, 256, 256}; pg8::LoraOrder S; S.so.init(3 * T_, 1024, G, bx);
        pg8::EpiLora E{LDf, ASb, GGb, INP(11), INP(13)};
        pg8::gemm_phase<pg8::EpiLora, pg8::LoraOrder, true, true>(L + RING_OFF, g, S, E);
        SEAM();
    }
    if (IN(5)) { PH_BEGIN();
        constexpr int TC = 32, NCH = SEQL / TC;
        constexpr int OPF = TC * 320, SCF = TC * 32, BUF_F = OPF + SCF;
        LAS float* SB = (LAS float*)(L + RING_OFF);
        LAS float* YS = SB + 2 * BUF_F;
        LAS float* YDM = YS + 2 * TC * 16;
        static_assert((2 * BUF_F + 2 * TC * 16) * 4 + 2304 <= 96768 && 96768 + 4 * 8448 <= RING_BYTES, "scan LDS map");
#define SCAN_BAR() do { asm volatile("s_waitcnt lgkmcnt(0)" ::: "memory"); __builtin_amdgcn_s_barrier(); asm volatile("" ::: "memory"); } while (0)
        int n_conv = 0;
        const int conv_first = vcu * 4 + (wave - 4), conv_stride = G * 4;
        const int conv_last = conv_first + ((3 * 32 * 1024 - 1 - conv_first) / conv_stride) * conv_stride;
#ifdef EXP_CONV_AFTER
        constexpr int N_CONV_IN = 0;
#else
        constexpr int N_CONV_IN = 3 * 32 * 1024;
#endif
        constexpr int N_CONV = 3 * 32 * 1024;
        const float* wg_ = INP(29); const float* wu_ = INP(30); const float* wd_ = INP(31);
        unsigned char* const WGU8 = (unsigned char*)WGUt; unsigned char* const WD8 = (unsigned char*)WDt;
        f32x4 cva[8], cvb[8];
#pragma unroll
        for (int i = 0; i < 8; ++i) { cva[i] = (f32x4){0.f, 0.f, 0.f, 0.f}; cvb[i] = (f32x4){0.f, 0.f, 0.f, 0.f}; }
        LAS float* cscr = (LAS float*)(L + ((wave & 3) < 3 ? 96768 + (wave & 3) * 8704 : 135168));
#define CONV_SRC(gi, W_, ldw_, k0_, n0_, WT_, ldk_, drow_) const float* W_; int ldw_, k0_, n0_, ldk_; size_t drow_; unsigned char* WT_; \
        if ((gi) < 65536) { const int up_ = (gi) >> 15, r_ = (gi) & 32767, e_ = r_ >> 10, kb_ = (r_ >> 5) & 31, nb_ = r_ & 31; n0_ = 32 * nb_; k0_ = 64 * kb_; W_ = (up_ ? wu_ : wg_) + (size_t)e_ * 2048 * 1024; ldw_ = 1024; \
            WT_ = WGU8; ldk_ = 2048; drow_ = (size_t)e_ * 2048 + (n0_ >> 7) * 256 + (n0_ & 127) + up_ * 128; } \
        else { const int it_ = (gi) - 65536, e_ = it_ >> 10, kb_ = (it_ >> 6) & 15, nb_ = it_ & 63; n0_ = 32 * nb_; k0_ = 64 * kb_; W_ = wd_ + (size_t)e_ * 1024 * 2048; ldw_ = 2048; WT_ = WD8; ldk_ = 1024; drow_ = (size_t)e_ * 2048 + n0_; }
#define CONV_ISSUE(gi, cv) do { CONV_SRC(gi, W_, ldw_, k0_, n0_, WT_, ldk_, drow_); (void)WT_; (void)ldk_; (void)drow_; int l_ = lane; asm volatile("" : "+v"(l_)); \
        const float* p_ = W_ + (size_t)(k0_ + (l_ >> 3)) * ldw_ + n0_ + 4 * (l_ & 7); \
        _Pragma("unroll") for (int i = 0; i < 8; ++i) cv[i] = *(const GAS f32x4*)(p_ + (size_t)(8 * i) * ldw_); } while (0)
#define CONV_FINISH(gi, cv) do { CONV_SRC(gi, W_, ldw_, k0_, n0_, WT_, ldk_, drow_); (void)W_; (void)ldw_; \
        { LAS float* w_ = cscr + (lane & 7) * 68 + (lane >> 3);                     \
          _Pragma("unroll") for (int i = 0; i < 8; ++i) { w_[8 * i] = cv[i].x; w_[8 * 68 + 8 * i] = cv[i].y; w_[16 * 68 + 8 * i] = cv[i].z; w_[24 * 68 + 8 * i] = cv[i].w; } } \
        LDS_WAIT(); asm volatile("" ::: "memory"); \
        { const int c4 = (lane >> 3) & 3; _Pragma("unroll") for (int j = 0; j < 2; ++j) { const int nl_ = (lane & 7) + 8 * ((lane >> 5) & 1) + 16 * j, n = 4 * (nl_ & 7) + (nl_ >> 3); \
            const LAS f32x4* s4_ = (const LAS f32x4*)(cscr + nl_ * 68 + 16 * c4);     \
            const f32x4 a_ = s4_[0] * SB_W, b_ = s4_[1] * SB_W, c_ = s4_[2] * SB_W, d_ = s4_[3] * SB_W; \
            v4u o; o.x = pk4f8(a_.x, a_.y, a_.z, a_.w); o.y = pk4f8(b_.x, b_.y, b_.z, b_.w); o.z = pk4f8(c_.x, c_.y, c_.z, c_.w); o.w = pk4f8(d_.x, d_.y, d_.z, d_.w); \
            *(GAS v4u*)(WT_ + (drow_ + n) * ldk_ + k0_ + 16 * c4) = o; } } \
        LDS_WAIT(); asm volatile("" ::: "memory"); } while (0)
        const float* k_k = INP(16); const float* k_a = INP(17); const float* r_k = INP(18);
        for (int unit = vcu; unit < 256; unit += G) {
            const int bh = unit >> 2, rq = unit & 3, b = bh >> 4, h = bh & 15;
            const size_t row0 = (size_t)b * SEQL;
            if (wave >= 4) {
                const int t2 = tid - 256, tk = t2 >> 3, part = t2 & 7, col = h * 64 + 8 * part;
                float kkc[8], kac[8], rkc[8];
#pragma unroll
                for (int i = 0; i < 8; ++i) { kkc[i] = k_k[col + i]; kac[i] = k_a[col + i]; rkc[i] = r_k[col + i]; }
                v4u rk8a, ra8a, rr8a, rv8a, rk8b, ra8b, rr8b, rv8b; f32x4 rl0a, rl1a, rl0b, rl1b;
#define SCAN_LOAD(c, X) do { const int cl_ = (c) < NCH ? (c) : NCH - 1; const size_t mrow = row0 + (size_t)cl_ * TC + tk; rk8##X = *(const GAS v4u*)(KSb + mrow * 1024 + col); ra8##X = *(const GAS v4u*)(ASb + mrow * 1024 + col); rr8##X = *(const GAS v4u*)(RSb + mrow * 1024 + col); \
        rl0##X = *(const GAS f32x4*)(LDf + mrow * 1024 + col); rl1##X = *(const GAS f32x4*)(LDf + mrow * 1024 + col + 4); rv8##X = *(const GAS v4u*)(VSb + mrow * 1024 + h * 64 + 16 * rq + 8 * (part & 1)); } while (0)
#define SCAN_STAGE(c, X) do { LAS float* B_ = SB + ((c) & 1) * BUF_F; float kv[8], av[8], rv[8], lv[8]; const v4u rk8 = rk8##X, ra8 = ra8##X, rr8 = rr8##X, rv8 = rv8##X; const f32x4 rl0 = rl0##X, rl1 = rl1##X; \
        kv[0] = bfl(rk8.x); kv[1] = bfh(rk8.x); kv[2] = bfl(rk8.y); kv[3] = bfh(rk8.y); kv[4] = bfl(rk8.z); kv[5] = bfh(rk8.z); kv[6] = bfl(rk8.w); kv[7] = bfh(rk8.w); \
        av[0] = bfl(ra8.x); av[1] = bfh(ra8.x); av[2] = bfl(ra8.y); av[3] = bfh(ra8.y); av[4] = bfl(ra8.z); av[5] = bfh(ra8.z); av[6] = bfl(ra8.w); av[7] = bfh(ra8.w); \
        rv[0] = bfl(rr8.x); rv[1] = bfh(rr8.x); rv[2] = bfl(rr8.y); rv[3] = bfh(rr8.y); rv[4] = bfl(rr8.z); rv[5] = bfh(rr8.z); rv[6] = bfl(rr8.w); rv[7] = bfh(rr8.w); \
        lv[0] = rl0.x; lv[1] = rl0.y; lv[2] = rl0.z; lv[3] = rl0.w; lv[4] = rl1.x; lv[5] = rl1.y; lv[6] = rl1.z; lv[7] = rl1.w; \
        float kkv[8], ss = 0.f, bs = 0.f, brs = 0.f, krs = 0.f; \
        _Pragma("unroll") for (int i = 0; i < 8; ++i) { kkv[i] = kv[i] * kkc[i]; ss += kkv[i] * kkv[i]; } \
        ss = oct_sum(ss); const float inv = 1.0f / fmaxf(sqrtf(ss), 1e-12f); \
        float ow[8], ok[8], ob[8], oa[8], oq[8]; \
        _Pragma("unroll") for (int i = 0; i < 8; ++i) { const float kk = kkv[i] * inv; ok[i] = kv[i] * (1.0f + (av[i] - 1.0f) * kac[i]); oa[i] = -kk; ob[i] = kk * av[i]; ow[i] = __expf(lv[i]); oq[i] = ow[i] * rv[i]; \
            bs += rv[i] * ok[i] * rkc[i]; brs += ob[i] * rv[i]; krs += ok[i] * rv[i]; } \
        bs = oct_sum(bs); brs = oct_sum(brs); krs = oct_sum(krs); \
        _Pragma("unroll") for (int i = 0; i < 8; ++i) oq[i] += brs * oa[i]; \
        if (rq == 0 && part == 0) BON[(row0 + (size_t)(c) * TC + tk) * 16 + h] = bs; \
        LAS float* d_ = B_ + tk * 320 + part * 40; \
        *(LAS f32x4*)(d_) = (f32x4){ow[0], ow[1], ow[2], ow[3]}; *(LAS f32x4*)(d_ + 4) = (f32x4){ok[0], ok[1], ok[2], ok[3]}; *(LAS f32x4*)(d_ + 8) = (f32x4){ob[0], ob[1], ob[2], ob[3]}; \
        *(LAS f32x4*)(d_ + 12) = (f32x4){oa[0], oa[1], oa[2], oa[3]}; *(LAS f32x4*)(d_ + 16) = (f32x4){oq[0], oq[1], oq[2], oq[3]}; \
        *(LAS f32x4*)(d_ + 20) = (f32x4){ow[4], ow[5], ow[6], ow[7]}; *(LAS f32x4*)(d_ + 24) = (f32x4){ok[4], ok[5], ok[6], ok[7]}; *(LAS f32x4*)(d_ + 28) = (f32x4){ob[4], ob[5], ob[6], ob[7]}; \
        *(LAS f32x4*)(d_ + 32) = (f32x4){oa[4], oa[5], oa[6], oa[7]}; *(LAS f32x4*)(d_ + 36) = (f32x4){oq[4], oq[5], oq[6], oq[7]}; \
        LAS float* ds_ = B_ + OPF + tk * 32 + 16 * part; \
        if (part < 2) { const float v0_ = bfl(rv8.x), v1_ = bfh(rv8.x), v2_ = bfl(rv8.y), v3_ = bfh(rv8.y), v4_ = bfl(rv8.z), v5_ = bfh(rv8.z), v6_ = bfl(rv8.w), v7_ = bfh(rv8.w); \
            *(LAS f32x4*)(ds_) = (f32x4){v0_, v0_ * krs, v1_, v1_ * krs}; *(LAS f32x4*)(ds_ + 4) = (f32x4){v2_, v2_ * krs, v3_, v3_ * krs}; \
            *(LAS f32x4*)(ds_ + 8) = (f32x4){v4_, v4_ * krs, v5_, v5_ * krs}; *(LAS f32x4*)(ds_ + 12) = (f32x4){v6_, v6_ * krs, v7_, v7_ * krs}; } } while (0)
#define SCAN_YOUT(c) do { const LAS float* ys = YS + ((c) & 1) * (TC * 16) + tk * 16 + 2 * part; const float y0 = ys[0], y1 = ys[1]; \
        float* yo = Yf + (row0 + (size_t)(c) * TC + tk) * 1024 + h * 64 + 16 * rq + 2 * part; *(GAS f32x2*)yo = (f32x2){y0, y1}; } while (0)
                SCAN_LOAD(0, a); SCAN_STAGE(0, a); SCAN_LOAD(1, b); SCAN_LOAD(2, a);
                { const int g0 = conv_first + n_conv * conv_stride, g1 = g0 + conv_stride; const int c0_ = g0 < conv_last ? g0 : conv_last, c1_ = g1 < conv_last ? g1 : conv_last; CONV_ISSUE(c0_, cva); CONV_ISSUE(c1_, cvb); }
                SCAN_BAR();
                static_assert(NCH % 2 == 0, "the chunk loop runs two chunks per trip (item parity = chunk parity)");
                for (int c2 = 0; c2 < NCH; c2 += 2) {
#pragma unroll
                    for (int cc = 0; cc < 2; ++cc) { const int c = c2 + cc;
                        if (cc == 0) { if (c + 1 < NCH) { SCAN_STAGE(c + 1, b); } SCAN_LOAD(c + 3, b); } else { if (c + 1 < NCH) { SCAN_STAGE(c + 1, a); } SCAN_LOAD(c + 3, a); }
                        if (c > 0) { SCAN_YOUT(c - 1); }
                        { const int gi = conv_first + n_conv * conv_stride, gj = gi + 2 * conv_stride; const int gjc = gj < conv_last ? gj : conv_last; const bool live = gi < N_CONV_IN;
                            if (cc == 0) { if (live) CONV_FINISH(gi, cva); CONV_ISSUE(gjc, cva); } else { if (live) CONV_FINISH(gi, cvb); CONV_ISSUE(gjc, cvb); }
                            n_conv += live ? 1 : 0; }
                        SCAN_BAR();
                    }
                }
                SCAN_YOUT(NCH - 1);
            } else {
                const int rl = lane >> 4, jq = lane & 15, il = 4 * wave + rl;
                f32x2 s01 = (f32x2){0.f, 0.f}, s23 = (f32x2){0.f, 0.f}; float dmy0 = 1.f, dmy1 = 1.f; (void)dmy0; (void)dmy1;
                SCAN_BAR();
                for (int c = 0; c < NCH; ++c) {
                    const LAS float* B_ = SB + (c & 1) * BUF_F + jq * 20; const LAS float* S_ = SB + (c & 1) * BUF_F + OPF;
                    LAS float* yw = (jq == 0) ? (YS + (c & 1) * (TC * 16) + il) : (YDM + lane);
                    f32x4 w4[2], k4[2], b4[2], a4[2], q4[2]; f32x2 vk[2];
#define SLOAD(t) do { const LAS float* o_ = B_ + (t) * 320; w4[(t) & 1] = *(const LAS f32x4*)(o_); k4[(t) & 1] = *(const LAS f32x4*)(o_ + 4); b4[(t) & 1] = *(const LAS f32x4*)(o_ + 8); a4[(t) & 1] = *(const LAS f32x4*)(o_ + 12); q4[(t) & 1] = *(const LAS f32x4*)(o_ + 16); \
        vk[(t) & 1] = *(const LAS f32x2*)(S_ + (t) * 32 + 2 * il); } while (0)
                    SLOAD(0); SLOAD(1);
#pragma unroll
                    for (int t = 0; t < TC; ++t) {
                        const f32x4 cw = w4[t & 1], ck = k4[t & 1], cb = b4[t & 1], ca = a4[t & 1], cq = q4[t & 1]; const f32x2 cvk = vk[t & 1];
                        if (t + 2 < TC) SLOAD(t + 2);
                        f32x2 ta = s01 * (f32x2){ca.x, ca.y}; ta = s23 * (f32x2){ca.z, ca.w} + ta;
                        f32x2 tq = s01 * (f32x2){cq.x, cq.y}; tq = s23 * (f32x2){cq.z, cq.w} + tq;
                        const f32x2 vv2 = (f32x2){cvk.x, cvk.x};
                        const f32x2 vk01 = vv2 * (f32x2){ck.x, ck.y}, vk23 = vv2 * (f32x2){ck.z, ck.w};
                        float psa = ta.x + ta.y, py = tq.x + tq.y;
                        psa += dpp_f(psa, 0); py += dpp_f(py, 0); psa += dpp_f(psa, 1); py += dpp_f(py, 1); psa += dpp_f(psa, 2); py += dpp_f(py, 2); psa += dpp_f(psa, 3); py += dpp_f(py, 3);
                        const float y = py + cvk.y;
                        const f32x2 sa2 = (f32x2){psa, psa};
                        s01 = s01 * (f32x2){cw.x, cw.y} + (sa2 * (f32x2){cb.x, cb.y} + vk01);
                        s23 = s23 * (f32x2){cw.z, cw.w} + (sa2 * (f32x2){cb.z, cb.w} + vk23);
                        yw[t * 16] = y;
                    }
#undef SLOAD
                    SCAN_BAR();
                }
            }
            SCAN_BAR();
        }
        if (wave >= 4) {
            for (int r = 0; r < 2; ++r) { const int gi = conv_first + n_conv * conv_stride; if (gi < N_CONV_IN) { if (n_conv & 1) CONV_FINISH(gi, cvb); else CONV_FINISH(gi, cva); ++n_conv; } }
            for (;;) { const int gi = conv_first + n_conv * conv_stride; if (gi >= N_CONV) break; CONV_ISSUE(gi, cva); CONV_FINISH(gi, cva); ++n_conv; } }
#undef SCAN_LOAD
#undef SCAN_STAGE
#undef SCAN_YOUT
#undef CONV_SRC
#undef CONV_ISSUE
#undef CONV_FINISH
#undef SCAN_BAR
        SEAM();
    }

    if (IN(6)) { PH_BEGIN();
        float lam;
        { const float a1 = INP(5)[lane] * INP(6)[lane], a2 = INP(7)[lane] * INP(8)[lane]; lam = __expf(wave_sum(a1)) - __expf(wave_sum(a2)) + 0.2f; }
        const float* sg = INP(9); const float* lng = INP(19); const float* lnb = INP(20);
        float sgl[16], lgl[16], lbl[16];
#pragma unroll
        for (int i = 0; i < 16; ++i) { sgl[i] = sg[16 * (lane & 7) + i] * 0.8f; lgl[i] = lng[16 * lane + i]; lbl[i] = lnb[16 * lane + i]; }
        for (int m = gw; m < T_; m += NGW) {
            {
                const int h = lane >> 3; const bfu* p0 = Ob + (size_t)m * 2048 + (2 * h) * 128 + 16 * (lane & 7); const bfu* p1 = p0 + 128;
                float o0[16], o1[16]; unpack16(*(const GAS v4u*)p0, *(const GAS v4u*)(p0 + 8), o0); unpack16(*(const GAS v4u*)p1, *(const GAS v4u*)(p1 + 8), o1);
                float ss = 0.f;
#pragma unroll
                for (int i = 0; i < 16; ++i) { o0[i] = o0[i] - lam * o1[i]; ss += o0[i] * o0[i]; }
                ss = oct_sum(ss);
                const float rstd = 1.0f / sqrtf(ss * (1.f / 128.f) + 1e-5f);
#pragma unroll
                for (int i = 0; i < 16; ++i) o0[i] = o0[i] * rstd * sgl[i];
                v4u oa, ob; pack16(o0, oa, ob); bfu* po = YAb + (size_t)m * 1024 + 16 * lane; *(GAS v4u*)po = oa; *(GAS v4u*)(po + 8) = ob;
            }
            {
                const float* yp = Yf + (size_t)m * 1024 + 16 * lane; float y[16];
#pragma unroll
                for (int i = 0; i < 4; ++i) { const f32x4 t = *(const GAS f32x4*)(yp + 4 * i); y[4 * i] = t.x; y[4 * i + 1] = t.y; y[4 * i + 2] = t.z; y[4 * i + 3] = t.w; }
#ifdef DBG_Y0
#pragma unroll
                for (int i = 0; i < 16; ++i) y[i] = (float)((i * 7 + lane) & 15) * 0.1f;
#endif
                float s = 0.f;
#pragma unroll
                for (int i = 0; i < 16; ++i) s += y[i];
                const float mean = quad_sum(s) * (1.f / 64.f); float q = 0.f;
#pragma unroll
                for (int i = 0; i < 16; ++i) { y[i] -= mean; q += y[i] * y[i]; }
                const float rstd = 1.0f / sqrtf(quad_sum(q) * (1.f / 64.f) + 64e-5f);
#ifdef DBG_BON0
                float bon; { const bfu* pa = ASb + (size_t)m * 1024 + 16 * lane; float aa[16]; unpack16(*(const GAS v4u*)pa, *(const GAS v4u*)(pa + 8), aa); float sa_ = 0.f;
#pragma unroll
                  for (int i = 0; i < 16; ++i) sa_ += aa[i] * (float)(i + 1); bon = quad_sum(sa_) * 0.01f; }
#else
                const float bon = BON[(size_t)m * 16 + (lane >> 2)];
#endif
                float vv[16], gg[16]; const bfu* pv = VSb + (size_t)m * 1024 + 16 * lane; const bfu* pg = GGb + (size_t)m * 1024 + 16 * lane;
                unpack16(*(const GAS v4u*)pv, *(const GAS v4u*)(pv + 8), vv); unpack16(*(const GAS v4u*)pg, *(const GAS v4u*)(pg + 8), gg);
#pragma unroll
                for (int i = 0; i < 16; ++i) y[i] = (y[i] * rstd * lgl[i] + lbl[i] + bon * vv[i]) * gg[i];
                v4u oa, ob; pack16(y, oa, ob); bfu* po = YBb + (size_t)m * 1024 + 16 * lane; *(GAS v4u*)po = oa; *(GAS v4u*)(po + 8) = ob;
            }
        }
        SEAM();
    }

    if (IN(7)) { PH_BEGIN();
        { pg8::Gemm g{YAb, WPAt, 1024, 1024}; pg8::StaticOrder S; S.init(T_, 2048, G, bx); pg8::EpiProj<0> E{Gb, 0, TMPb, MRGb, 1.0f};
          pg8::gemm_phase<pg8::EpiProj<0>, pg8::StaticOrder, true, true>(L + RING_OFF, g, S, E); }
        { pg8::Gemm g{YBb, WPBt, 1024, 1024}; pg8::StaticOrder S; S.init(T_, 2048, G, bx); pg8::EpiProj<1> E{Gb, 2048, TMPb, MRGb, WOUT_F8 ? SA_M : 1.0f};
          pg8::gemm_phase<pg8::EpiProj<1>, pg8::StaticOrder, true, true>(L + RING_OFF, g, S, E); }
        SEAM();
    }

    if (IN(8)) { PH_BEGIN();
        pg8::Gemm g{MRGb, WOUTt, 2048, 2048}; pg8::StaticOrder S; S.init(T_, 2048, G, bx); pg8::EpiBf16 E{DELTAb, 2048, 1.0f};
        pg8::gemm_phase<pg8::EpiBf16, pg8::StaticOrder, true, true>(L + RING_OFF, g, S, E);
        SEAM();
    }

#define TT ((LAS int*)(L + TT_OFF))
#define TB_BASE ((LAS int*)(L + TT_OFF + 1024))
    if (IN(9)) { PH_BEGIN();
        LAS float* LG = (LAS float*)(L + RING_OFF);
        LAS float* RS = (LAS float*)(L + RING_OFF + 12288);
        LAS unsigned* hist = (LAS unsigned*)(L + RING_OFF + 16384);
        const float* xin = INP(0); const float* bg = INP(26); const float* be = INP(28);
        for (int tb = vcu; tb < 256; tb += G) {
            if (tid < 32) hist[tid] = 0u;
            __syncthreads();
            int e1 = 0, e2 = 0; unsigned q1 = 0u, q2 = 0u; float gt1 = 0.f, gt2 = 0.f;
            if (wave < 4) {
                const int r = lane & 15, q = lane >> 4; const int tok = tb * 64 + wave * 16 + r;
                const float* xr = xin + (size_t)tok * 2048 + 8 * q; const bfu* dr = DELTAb + (size_t)tok * 2048 + 8 * q; bfu* ur = Hb + (size_t)tok * 2048 + 8 * q;
                const bfu* rt = WRTt + (size_t)r * 2048 + 8 * q;
                f32x4 acc0 = (f32x4){0.f, 0.f, 0.f, 0.f}, acc1 = acc0, acc2 = acc0; float ss = 0.f;
#pragma unroll 4
                for (int s = 0; s < 64; ++s) {
                    const f32x4 xa = *(const GAS f32x4*)(xr + 32 * s), xb = *(const GAS f32x4*)(xr + 32 * s + 4); const v4u dd = *(const GAS v4u*)(dr + 32 * s);
                    const v4u b0 = *(const GAS v4u*)(rt + 32 * s), b1 = *(const GAS v4u*)(rt + 16 * 2048 + 32 * s), b2 = *(const GAS v4u*)(rt + 32 * 2048 + 32 * s);
                    float x[8];
                    x[0] = xa.x + bfl(dd.x); x[1] = xa.y + bfh(dd.x); x[2] = xa.z + bfl(dd.y); x[3] = xa.w + bfh(dd.y); x[4] = xb.x + bfl(dd.z); x[5] = xb.y + bfh(dd.z); x[6] = xb.z + bfl(dd.w); x[7] = xb.w + bfh(dd.w);
#pragma unroll
                    for (int i = 0; i < 8; ++i) ss += x[i] * x[i];
                    v4u u; u.x = pk2(x[0], x[1]); u.y = pk2(x[2], x[3]); u.z = pk2(x[4], x[5]); u.w = pk2(x[6], x[7]);
                    *(GAS v4u*)(ur + 32 * s) = u;
                    const bf16x8 af = __builtin_bit_cast(bf16x8, u);
                    acc0 = __builtin_amdgcn_mfma_f32_16x16x32_bf16(af, __builtin_bit_cast(bf16x8, b0), acc0, 0, 0, 0);
                    acc1 = __builtin_amdgcn_mfma_f32_16x16x32_bf16(af, __builtin_bit_cast(bf16x8, b1), acc1, 0, 0, 0);
                    acc2 = __builtin_amdgcn_mfma_f32_16x16x32_bf16(af, __builtin_bit_cast(bf16x8, b2), acc2, 0, 0, 0);
                }
                ss += __shfl_xor(ss, 16); ss += __shfl_xor(ss, 32);
                const float rstd = 1.0f / sqrtf(ss * (1.f / 2048.f) + 1e-6f);
                if (q == 0) { RSTD[tok] = rstd; RS[wave * 16 + r] = rstd; }
                LDS_WAIT(); asm volatile("" ::: "memory");
                LAS float* lgw = LG + wave * (16 * 48);
#pragma unroll
                for (int i = 0; i < 4; ++i) { const float rs_ = RS[wave * 16 + 4 * q + i]; lgw[(4 * q + i) * 48 + r] = acc0[i] * rs_; lgw[(4 * q + i) * 48 + 16 + r] = acc1[i] * rs_; lgw[(4 * q + i) * 48 + 32 + r] = acc2[i] * rs_; }
                LDS_WAIT(); asm volatile("" ::: "memory");
                if (lane < 16) {
                    const LAS float* lr = lgw + lane * 48; float lg[36];
#pragma unroll
                    for (int c4 = 0; c4 < 9; ++c4) { const f32x4 t = *(const LAS f32x4*)(lr + 4 * c4); lg[4 * c4] = t.x; lg[4 * c4 + 1] = t.y; lg[4 * c4 + 2] = t.z; lg[4 * c4 + 3] = t.w; }
                    int gi = 0; float gm = lg[0] + bg[0]; float gl[4];
#pragma unroll
                    for (int i = 0; i < 4; ++i) { gl[i] = lg[i] + bg[i]; if (gl[i] > gm) { gm = gl[i]; gi = i; } }
                    float gs = 0.f;
#pragma unroll
                    for (int i = 0; i < 4; ++i) gs += __expf(gl[i] - gm);
                    const float pg = 1.0f / gs;
                    float el[8];
#pragma unroll
                    for (int j = 0; j < 8; ++j) { float v = 0.f;
#pragma unroll
                        for (int gg = 0; gg < 4; ++gg) v = (gg == gi) ? (lg[4 + gg * 8 + j] + be[gg * 8 + j]) : v;
                        el[j] = v; }
                    int i1 = 0; float m1 = el[0];
#pragma unroll
                    for (int j = 1; j < 8; ++j) if (el[j] > m1) { m1 = el[j]; i1 = j; }
                    int i2 = -1; float m2 = -INFINITY;
#pragma unroll
                    for (int j = 0; j < 8; ++j) if (j != i1 && el[j] > m2) { m2 = el[j]; i2 = j; }
                    const float p2 = __expf(m2 - m1); gt1 = pg / (1.0f + p2); gt2 = pg * p2 / (1.0f + p2);
                    e1 = gi * 8 + i1; e2 = gi * 8 + i2;
                    q1 = atomicAdd((unsigned*)(hist + e1), 1u); q2 = atomicAdd((unsigned*)(hist + e2), 1u);
                    const int tk = tb * 64 + wave * 16 + lane;
                    ASG_E[2 * tk] = e1; ASG_E[2 * tk + 1] = e2; ASG_POS[2 * tk] = (int)q1; ASG_POS[2 * tk + 1] = (int)q2; ASG_GATE[2 * tk] = gt1; ASG_GATE[2 * tk + 1] = gt2;
                }
            }
            __syncthreads();
            if (tid < 32) CNTT[tb * 32 + tid] = (int)hist[tid];
            __syncthreads();
        }
        SEAM();
    }

#define MOE_TABLES(tbsel) do { LAS int* tot_ = (LAS int*)(L + TT_OFF + 1280); \
        if (tid < 32) { int run = 0, mine = 0; _Pragma("unroll 8") for (int t2 = 0; t2 < 256; ++t2) { if (t2 == (tbsel)) mine = run; run += CNTT[t2 * 32 + tid]; } tot_[tid] = run; TB_BASE[tid] = mine; } \
        __syncthreads(); \
        if (tid == 0) { int off = 0, nt = 0; for (int e = 0; e < 32; ++e) { const int c = tot_[e]; TT[e] = off; const int n = (c + 255) >> 8; for (int k = 0; k < n; ++k) TT[33 + nt + k] = e; nt += n; off += n * 256; } TT[32] = nt; } \
        __syncthreads(); } while (0)
    if (IN(10)) { PH_BEGIN();
        float g2a[16], g2b[16]; { const float* g2p = INP(24) + 32 * lane;
#pragma unroll
            for (int i = 0; i < 16; ++i) { g2a[i] = g2p[i] * SA_H; g2b[i] = g2p[16 + i] * SA_H; } }
        for (int tb = vcu; tb < 256; tb += G) {
            MOE_TABLES(tb);
            const int my_a = tb * 128 + wave * 16 + (lane & 15);
            const int my_e = ASG_E[my_a], my_lp = ASG_POS[my_a]; const float my_gate = ASG_GATE[my_a], my_rs = RSTD[my_a >> 1];
            const int my_dest = TT[my_e] + TB_BASE[my_e] + my_lp;
            if (lane < 16) { ROWGATE[my_dest] = my_gate; TOKDEST[my_a] = my_dest; }
#pragma unroll 4
            for (int i = 0; i < 16; ++i) { const int t = (tb * 128 + wave * 16 + i) >> 1; const int dest = __shfl(my_dest, i); const float sc = __shfl(my_rs, i);
                const GAS v4u* src = (const GAS v4u*)(Hb + (size_t)t * 2048 + 32 * lane); GAS v4u* dst = (GAS v4u*)((unsigned char*)XGb + (size_t)dest * 2048 + 32 * lane);
                float xa[16], xb[16]; unpack16(src[0], src[1], xa); unpack16(src[2], src[3], xb);
#pragma unroll
                for (int j = 0; j < 16; ++j) { xa[j] *= g2a[j]; xb[j] *= g2b[j]; }
                v4u o0, o1;
                o0.x = pk4f8c(xa[0] * sc, xa[1] * sc, xa[2] * sc, xa[3] * sc); o0.y = pk4f8c(xa[4] * sc, xa[5] * sc, xa[6] * sc, xa[7] * sc);
                o0.z = pk4f8c(xa[8] * sc, xa[9] * sc, xa[10] * sc, xa[11] * sc); o0.w = pk4f8c(xa[12] * sc, xa[13] * sc, xa[14] * sc, xa[15] * sc);
                o1.x = pk4f8c(xb[0] * sc, xb[1] * sc, xb[2] * sc, xb[3] * sc); o1.y = pk4f8c(xb[4] * sc, xb[5] * sc, xb[6] * sc, xb[7] * sc);
                o1.z = pk4f8c(xb[8] * sc, xb[9] * sc, xb[10] * sc, xb[11] * sc); o1.w = pk4f8c(xb[12] * sc, xb[13] * sc, xb[14] * sc, xb[15] * sc);
                dst[0] = o0; dst[1] = o1; }
            __syncthreads();
        }
        SEAM();
    }

    if (IN(11)) { PH_BEGIN();
        if (lo == 11) MOE_TABLES(-1);
        const int ntiles = __builtin_amdgcn_readfirstlane(TT[32]);
        pg8::Gemm g{XGb, WGUt, 1024, 1024}; pg8::MoeOrder S; S.so.init(ntiles * 256, 2048, G, bx); S.tile_e = (const LAS int*)(TT + 33); pg8::EpiGU E{(unsigned char*)ACTb, 1.0f / (SA_H * SB_W), SA_ACT};
        pg8::gemm_phase8<pg8::EpiGU, pg8::MoeOrder, true, true>(L + RING_OFF, g, S, E);
        SEAM();
    }
    if (IN(12)) { PH_BEGIN();
        if (lo == 12) MOE_TABLES(-1);
        const int ntiles = __builtin_amdgcn_readfirstlane(TT[32]);
        pg8::Gemm g{ACTb, WDt, 512, 512}; pg8::MoeOrder S; S.so.init(ntiles * 256, 2048, G, bx); S.tile_e = (const LAS int*)(TT + 33); pg8::EpiDown E{YDb, ROWGATE, 1.0f / (SA_ACT * SB_W)};
        pg8::gemm_phase8<pg8::EpiDown, pg8::MoeOrder, true, true>(L + RING_OFF, g, S, E);
        SEAM();
    }
    if (IN(13)) { PH_BEGIN();
        int td_ = 0; { const int mi = gw + (lane >> 1) * NGW; if (mi < T_) td_ = TOKDEST[2 * mi + (lane & 1)]; }
        int kk_ = 0;
        for (int m = gw; m < T_; m += NGW, ++kk_) { const int d0 = __shfl(td_, (2 * kk_) & 63), d1 = __shfl(td_, (2 * kk_ + 1) & 63);
            GAS f32x4* o = (GAS f32x4*)(OUTP + (size_t)m * 2048) + lane; const GAS u32x2* dl = (const GAS u32x2*)(Hb + (size_t)m * 2048) + lane;
            const GAS u32x2* y0 = (const GAS u32x2*)(YDb + (size_t)d0 * 2048) + lane; const GAS u32x2* y1 = (const GAS u32x2*)(YDb + (size_t)d1 * 2048) + lane;
#pragma unroll
            for (int j = 0; j < 8; ++j) { const u32x2 a = y0[64 * j], b = y1[64 * j], d = dl[64 * j]; f32x4 v;
                v.x = bfl(d.x) + (bfl(a.x) + bfl(b.x)); v.y = bfh(d.x) + (bfh(a.x) + bfh(b.x)); v.z = bfl(d.y) + (bfl(a.y) + bfl(b.y)); v.w = bfh(d.y) + (bfh(a.y) + bfh(b.y)); o[64 * j] = v; } }
    }
#undef IN
#undef SEAM
}

#ifndef N_PHASES_
#define N_PHASES_ 14
#endif
constexpr int N_PHASES = N_PHASES_;
extern "C" void kernel_launch(void* const* d_in, const int* in_sizes, int n_in, void* d_out, int out_size, void* d_ws, size_t ws_size, hipStream_t stream) {
    static int grid = 0;
    if (grid == 0) {
        if (n_in != 32 || out_size != T_ * DMODEL || ws_size < WS_END) { fprintf(stderr, "kernel_launch: unexpected problem (n_in %d, out %d, ws %zu)\n", n_in, out_size, ws_size); grid = -1; return; }
        int dev = 0, cus = 0, per_cu = 0;
        if (hipGetDevice(&dev) != hipSuccess || hipDeviceGetAttribute(&cus, hipDeviceAttributeMultiprocessorCount, dev) != hipSuccess) { grid = -1; return; }
        if (hipFuncSetAttribute((const void*)mk_fwd, hipFuncAttributeMaxDynamicSharedMemorySize, LDS_BYTES) != hipSuccess) { fprintf(stderr, "kernel_launch: hipFuncSetAttribute failed\n"); grid = -1; return; }
        if (hipOccupancyMaxActiveBlocksPerMultiprocessor(&per_cu, (const void*)mk_fwd, NWAVES * 64, LDS_BYTES) != hipSuccess || per_cu < 1) fprintf(stderr, "kernel_launch: occupancy query reports %d\n", per_cu);
        (void)hipGetLastError();
        grid = cus;
    }
    if (grid < 0) return;
    if (hipMemsetAsync((char*)d_ws + WS_CTL, 0, CTL_ZERO_BYTES, stream) != hipSuccess) return;
    Args a{};
    for (int i = 0; i < 32; ++i) a.in[i] = (const float*)d_in[i];
    a.out = (float*)d_out; a.ws = (unsigned char*)d_ws;
#if defined(DUP_PH)
    { const int cuts[4] = {0, DUP_PH + 1, DUP_PH, N_PHASES}; const int ends[3] = {DUP_PH + 1, DUP_PH + 1, N_PHASES};
      for (int l = 0; l < 3; ++l) { a.ph_lo = cuts[l == 2 ? 1 : (l == 1 ? 2 : 0)]; a.ph_hi = ends[l]; a.li = l; hipLaunchKernelGGL(mk_fwd, dim3(grid), dim3(NWAVES * 64), LDS_BYTES, stream, a); } }
#elif MK_SPLIT
    for (int p = 0; p < N_PHASES; ++p) { a.ph_lo = p; a.ph_hi = p + 1; hipLaunchKernelGGL(mk_fwd, dim3(grid), dim3(NWAVES * 64), LDS_BYTES, stream, a); }
#else
    a.ph_lo = 0; a.ph_hi = N_PHASES; hipLaunchKernelGGL(mk_fwd, dim3(grid), dim3(NWAVES * 64), LDS_BYTES, stream, a);
#endif
}
```

```cpp
#include <hip/hip_runtime.h>
#include <hip/hip_bf16.h>
#include <cstdio>
#include <cstdint>
#include <cmath>

#ifndef WOUT_F8
#define WOUT_F8 0
#endif
#ifndef PROJ_F8
#define PROJ_F8 1
#endif
#ifndef DBG_ACC
#define DBG_ACC(x) (x)
#endif
#ifndef MK_SPLIT
#define MK_SPLIT 0
#endif

namespace pg8 {
#define PG8_LAS __attribute__((address_space(3)))
typedef unsigned short bf16_t;
typedef short bf16x8 __attribute__((ext_vector_type(8)));
typedef float f32x4 __attribute__((ext_vector_type(4)));
typedef unsigned u32x4 __attribute__((ext_vector_type(4)));
constexpr int BM = 256, BK = 64, HALF = 128, HTB = HALF * BK * 2  , STAGE_BYTES = 8 * HTB, NXCD = 8, WGM = 8;

__host__ __device__ __forceinline__ int lds_byte(int r, int c) { const int st = (r >> 4) * 2 + (c >> 5), rr = r & 15, cc = c & 31, ob = rr * 64 + cc * 2; return st * 1024 + (ob ^ (((ob >> 9) & 1) << 5)); }
__host__ __device__ __forceinline__ void stage_rc(int b, int& R, int& C) { const int st = b / 1024, sb = b % 1024, swz = sb ^ (((sb >> 9) & 1) << 5); R = (st >> 1) * 16 + swz / 64; C = (st & 1) * 32 + (swz % 64) / 2; }
__host__ __device__ __forceinline__ int perm32(int rho) { const int n = rho >> 4, i = rho & 15; return 8 * (i >> 2) + 4 * n + (i & 3); }

struct Unit { int pm, pn, pb, ko; };
struct Gemm { const bf16_t* A; const bf16_t* Bt; int K, ld; };

struct StaticOrder {
    int nM, nN, nwg, G, c;
    __host__ __device__ void init(int M, int N, int G_, int c_) { nM = M / BM; nN = N / BM; nwg = nM * nN; G = G_; c = c_; }
    __host__ __device__ bool next(int i, Unit& u) const { return at(i * G + c, u); }
    __host__ __device__ bool at(int L, Unit& u) const {
        if (L >= nwg) return false;
        int wgid = L; { const int q = nwg / NXCD, r = nwg % NXCD, xcd = wgid % NXCD, off = wgid / NXCD; wgid = (xcd < r ? xcd * (q + 1) : r * (q + 1) + (xcd - r) * q) + off; }
        return at_w(wgid, u);
    }
    __host__ __device__ bool at_w(int wgid, Unit& u) const {
        const int nig = WGM * nN, gid = wgid / nig, fm = gid * WGM, gsz = (nM - fm) < WGM ? (nM - fm) : WGM;
        u.pm = fm + ((wgid % nig) % gsz); u.pn = (wgid % nig) / gsz; u.pb = u.pn; u.ko = 0; return true;
    }
};
struct WinOrder {
    StaticOrder so; int f8;
    __device__ __forceinline__ bool next(int i, Unit& u) const {
        bool ok;
        if (so.G == 256) { const int x = so.c & 7, o = i * 32 + (so.c >> 3);
            const int cnt = f8 ? (x < 4 ? 128 : 192) : (x < 4 ? 192 : 160), start = f8 ? (x < 4 ? 128 * x : 512 + 192 * (x - 4)) : (x < 4 ? 192 * x : 768 + 160 * (x - 4));
            ok = (o < cnt) && so.at_w(start + o, u); }
        else ok = so.next(i, u);
        if (!ok) return false;
        const int p = u.pn; u.pn = f8 ? (p < 4 ? 8 + p : 22 + p) : (p < 8 ? p : p + 4); u.pb = u.pn; return true; }
};
struct LoraOrder {
    StaticOrder so;
    __device__ __forceinline__ bool next(int i, Unit& u) const { if (!so.next(i, u)) return false; u.pb = (u.pm >> 6) * 4 + u.pn; return true; }
};
struct RouterOrder {
    int G, c;
    __device__ __forceinline__ bool next(int i, Unit& u) const { const int L = i * G + c; if (L >= 256) return false; u.pm = L >> 2; u.pn = 0; u.pb = 0; u.ko = (L & 3) * 512; return true; }
};
struct MoeOrder {
    StaticOrder so; const PG8_LAS int* tile_e;
    __device__ __forceinline__ bool next(int i, Unit& u) const { if (!so.next(i, u)) return false; u.pb = __builtin_amdgcn_readfirstlane(tile_e[u.pm]) * 8 + u.pn; return true; }
};

typedef float f32x2_t __attribute__((ext_vector_type(2))); typedef __bf16 bf16x2_t __attribute__((ext_vector_type(2)));
__device__ __forceinline__ unsigned cvt_pk_bf16(float lo, float hi) { f32x2_t v = {lo, hi}; bf16x2_t b = __builtin_convertvector(v, bf16x2_t); return __builtin_bit_cast(unsigned, b); }
__device__ __forceinline__ float bf_lo(unsigned w) { return __uint_as_float(w << 16); }
__device__ __forceinline__ float bf_hi(unsigned w) { return __uint_as_float(w & 0xffff0000u); }
__device__ __forceinline__ float sigmoidf_(float x) { return __builtin_amdgcn_rcpf(1.0f + __expf(-x)); }
__device__ __forceinline__ u32x4 pack8(const f32x4 v0, const f32x4 v1) { u32x4 w; w.x = cvt_pk_bf16(v0[0], v0[1]); w.y = cvt_pk_bf16(v0[2], v0[3]); w.z = cvt_pk_bf16(v1[0], v1[1]); w.w = cvt_pk_bf16(v1[2], v1[3]); return w; }
__device__ __forceinline__ void unpack8(const u32x4 w, f32x4& v0, f32x4& v1) { v0 = (f32x4){bf_lo(w.x), bf_hi(w.x), bf_lo(w.y), bf_hi(w.y)}; v1 = (f32x4){bf_lo(w.z), bf_hi(w.z), bf_lo(w.w), bf_hi(w.w)}; }

__device__ __forceinline__ float clamp_f8(float x) { return __builtin_amdgcn_fmed3f(x, -448.f, 448.f); }
__device__ __forceinline__ unsigned pk4_fp8(float a, float b, float c, float d) { int w = 0; w = __builtin_amdgcn_cvt_pk_fp8_f32(clamp_f8(a), clamp_f8(b), w, false); w = __builtin_amdgcn_cvt_pk_fp8_f32(clamp_f8(c), clamp_f8(d), w, true); return (unsigned)w; }
typedef unsigned u32x2_ __attribute__((ext_vector_type(2)));

#define PG8_EPI_LOOP_BEGIN \
    _Pragma("unroll") for (int ai = 0; ai < 2; ++ai) _Pragma("unroll") for (int m = 0; m < 4; ++m) { const int row = u.pm * BM + ai * HALF + wr * 64 + m * 16 + fr; \
        _Pragma("unroll") for (int bj = 0; bj < 2; ++bj) { const int colr = bj * HALF + wc * 32 + 8 * fq; f32x4 v0 = acc[ai][bj][m][0], v1 = acc[ai][bj][m][1];
#define PG8_EPI_LOOP_END } }

struct EpiWin {
    static constexpr bool PERM = true;
    bf16_t *Q, *K, *V, *RW, *G; float sc;
    __device__ __forceinline__ void operator()(const f32x4 (&acc)[2][2][4][2], const Unit& u, int wr, int wc, int fr, int fq) const {
        bf16_t* base; int ldc, colt; const int pn = u.pn;
        if (pn < 4) { base = Q; ldc = 1024; colt = pn * 256; } else if (pn < 8) { base = K; ldc = 1024; colt = (pn - 4) * 256; } else if (pn < 12) { base = V; ldc = 1024; colt = (pn - 8) * 256; }
        else if (pn < 26) { base = RW; ldc = 3584; colt = (pn - 12) * 256; } else { base = G; ldc = 4096; colt = (pn - 26) * 256; }
        PG8_EPI_LOOP_BEGIN
            *(u32x4*)(base + (size_t)row * ldc + colt + colr) = pack8(v0 * sc, v1 * sc);
        PG8_EPI_LOOP_END
    }
};
struct EpiLora {
    static constexpr bool PERM = true;
    float* LD; bf16_t* AS; bf16_t* GG; const float* w0; const float* a0;
    __device__ __forceinline__ void operator()(const f32x4 (&acc)[2][2][4][2], const Unit& u0, int wr, int wc, int fr, int fq) const {
        const int which = u0.pm >> 6; Unit u = u0; u.pm = u0.pm & 63; const int colt = u.pn * 256;
        PG8_EPI_LOOP_BEGIN
            const int col = colt + colr; const size_t off = (size_t)row * 1024 + col;
            if (which == 0) { const f32x4 b0 = *(const f32x4*)(w0 + col), b1 = *(const f32x4*)(w0 + col + 4); f32x4 o0, o1;
#pragma unroll
                for (int j = 0; j < 4; ++j) { float z = -(v0[j] + b0[j]); float sp = fmaxf(z, 0.f) + __logf(1.0f + __expf(-fabsf(z))); o0[j] = -__expf(-sp - 0.5f);
                                              z = -(v1[j] + b1[j]); sp = fmaxf(z, 0.f) + __logf(1.0f + __expf(-fabsf(z))); o1[j] = -__expf(-sp - 0.5f); }
                *(f32x4*)(LD + off) = o0; *(f32x4*)(LD + off + 4) = o1; }
            else if (which == 1) { const f32x4 b0 = *(const f32x4*)(a0 + col), b1 = *(const f32x4*)(a0 + col + 4);
#pragma unroll
                for (int j = 0; j < 4; ++j) { v0[j] = sigmoidf_(DBG_ACC(v0[j]) + b0[j]); v1[j] = sigmoidf_(DBG_ACC(v1[j]) + b1[j]); }
                *(u32x4*)(AS + off) = pack8(v0, v1); }
            else { *(u32x4*)(GG + off) = pack8(v0, v1); }
        PG8_EPI_LOOP_END
    }
};
template <int MODE> struct EpiProj {
    static constexpr bool PERM = true;
    const bf16_t* G; int goff; bf16_t* TMP; bf16_t* OUT; float osc, isc;
    __device__ __forceinline__ void operator()(const f32x4 (&acc)[2][2][4][2], const Unit& u, int wr, int wc, int fr, int fq) const {
        const int colt = u.pn * 256;
        PG8_EPI_LOOP_BEGIN
            const int col = colt + colr; const u32x4 gw = *(const u32x4*)(G + (size_t)row * 4096 + goff + col); f32x4 g0, g1; unpack8(gw, g0, g1);
#pragma unroll
            for (int j = 0; j < 4; ++j) { v0[j] *= sigmoidf_(g0[j]) * isc; v1[j] *= sigmoidf_(g1[j]) * isc; }
#ifdef DBG_NO_YA
            if (MODE == 0) { v0 *= 0.f; v1 *= 0.f; }
#endif
#ifdef DBG_NO_YB
            if (MODE == 1) { v0 *= 0.f; v1 *= 0.f; }
#endif
            if (MODE == 1) { const u32x4 tw = *(const u32x4*)(TMP + (size_t)row * 2048 + col); f32x4 t0, t1; unpack8(tw, t0, t1); v0 = (v0 + t0) * osc; v1 = (v1 + t1) * osc;
                if (WOUT_F8) { u32x2_ w; w.x = pk4_fp8(v0[0], v0[1], v0[2], v0[3]); w.y = pk4_fp8(v1[0], v1[1], v1[2], v1[3]); *(u32x2_*)((unsigned char*)OUT + (size_t)row * 2048 + col) = w; }
                else *(u32x4*)(OUT + (size_t)row * 2048 + col) = pack8(v0, v1); }
            else *(u32x4*)(TMP + (size_t)row * 2048 + col) = pack8(v0, v1);
        PG8_EPI_LOOP_END
    }
};
struct EpiRes {
    static constexpr bool PERM = true;
    const float* X; float* O; float sc;
    __device__ __forceinline__ void operator()(const f32x4 (&acc)[2][2][4][2], const Unit& u, int wr, int wc, int fr, int fq) const {
        const int colt = u.pn * 256;
        PG8_EPI_LOOP_BEGIN
            const size_t off = (size_t)row * 2048 + colt + colr;
            *(f32x4*)(O + off) = v0 * sc + *(const f32x4*)(X + off); *(f32x4*)(O + off + 4) = v1 * sc + *(const f32x4*)(X + off + 4);
        PG8_EPI_LOOP_END
    }
};
struct EpiBf16 {
    static constexpr bool PERM = true;
    bf16_t* O; int ldc; float sc;
    __device__ __forceinline__ void operator()(const f32x4 (&acc)[2][2][4][2], const Unit& u, int wr, int wc, int fr, int fq) const {
        const int colt = u.pn * 256;
        PG8_EPI_LOOP_BEGIN
            *(u32x4*)(O + (size_t)row * ldc + colt + colr) = pack8(v0 * sc, v1 * sc);
        PG8_EPI_LOOP_END
    }
};
struct EpiRouter {
    static constexpr bool PERM = true;
    float* LG;
    __device__ __forceinline__ void operator()(const f32x4 (&acc)[2][2][4][2], const Unit& u, int wr, int wc, int fr, int fq) const {
        float* base = LG + (size_t)(u.ko >> 9) * 16384 * 64;
        PG8_EPI_LOOP_BEGIN
            if (bj == 0 && wc < 2) { float* p = base + (size_t)row * 64 + colr; *(f32x4*)p = v0; *(f32x4*)(p + 4) = v1; }
        PG8_EPI_LOOP_END
    }
};
struct EpiGU {
    static constexpr bool PERM = true;
    unsigned char* ACT; float sc_in, sc_out;
    __device__ __forceinline__ void operator()(const f32x4 (&acc)[2][2][4][2], const Unit& u, int wr, int wc, int fr, int fq) const {
#pragma unroll
        for (int ai = 0; ai < 2; ++ai)
#pragma unroll
            for (int m = 0; m < 4; ++m) { const int row = u.pm * BM + ai * HALF + wr * 64 + m * 16 + fr; const int col = u.pn * 128 + wc * 32 + 8 * fq;
                f32x4 g0 = acc[ai][0][m][0] * sc_in, g1 = acc[ai][0][m][1] * sc_in; const f32x4 u0 = acc[ai][1][m][0] * (sc_in * sc_out), u1 = acc[ai][1][m][1] * (sc_in * sc_out);
#pragma unroll
                for (int j = 0; j < 4; ++j) { g0[j] = g0[j] * sigmoidf_(g0[j]) * u0[j]; g1[j] = g1[j] * sigmoidf_(g1[j]) * u1[j]; }
                u32x2_ w; w.x = pk4_fp8(g0[0], g0[1], g0[2], g0[3]); w.y = pk4_fp8(g1[0], g1[1], g1[2], g1[3]);
                *(u32x2_*)(ACT + (size_t)row * 1024 + col) = w; }
    }
};
struct EpiDown {
    static constexpr bool PERM = true;
    bf16_t* YD; const float* gate; float sc_in;
    __device__ __forceinline__ void operator()(const f32x4 (&acc)[2][2][4][2], const Unit& u, int wr, int wc, int fr, int fq) const {
        const int colt = u.pn * 256;
        PG8_EPI_LOOP_BEGIN
            const float gt = gate[row] * sc_in; v0 *= gt; v1 *= gt;
            *(u32x4*)(YD + (size_t)row * 2048 + colt + colr) = pack8(v0, v1);
        PG8_EPI_LOOP_END
    }
};

template <class Epi, class Sched, bool ALIGN_EPI = false, bool SP2 = false>
__device__ __forceinline__ void gemm_phase(PG8_LAS unsigned char* lds, const Gemm g, const Sched& S, const Epi& E) {
    int tid_ = threadIdx.x; asm volatile("" : "+v"(tid_));
    const int tid = tid_, wid = __builtin_amdgcn_readfirstlane(tid >> 6), lane = tid & 63, wr = wid >> 2, wc = wid & 3, fr = lane & 15, fq = lane >> 4;
    const int K = g.K, nt = K / BK, LD = g.ld;
    unsigned voffA[2], voffB[2];
#pragma unroll
    for (int i = 0; i < 2; ++i) { int R, C; stage_rc(tid * 16 + i * 8192, R, C); const int Rb = Epi::PERM ? ((R & ~31) + perm32(R & 31)) : R;
        voffA[i] = (unsigned)(R * LD + C) * 2u; voffB[i] = (unsigned)(Rb * LD + C) * 2u; }
    const size_t kstep = (size_t)(BK * 2);
    const size_t hstep = (size_t)HALF * LD * 2;
    const size_t tstep = 2 * hstep;
    const unsigned ldsw = (unsigned)wid * 1024u;
    const int aoff = lds_byte(wr * 64 + fr, fq * 8), boff = lds_byte(wc * 32 + fr, fq * 8);
#define PG8_SA(b, h) (((b) * 2 + (h)) * HTB)
#define PG8_SB(b, h) ((4 + (b) * 2 + (h)) * HTB)
#define PG8_STAGE(bufoff, gbase, voff) do { _Pragma("unroll") for (int _i = 0; _i < 2; ++_i) \
        __builtin_amdgcn_global_load_lds((const unsigned*)((const char*)(gbase) + (voff)[_i]), (PG8_LAS unsigned*)(lds + (bufoff) + ldsw + _i * 8192), 16, 0, 0); } while (0)
#define PG8_LDA(dst, b, h) do { _Pragma("unroll") for (int m = 0; m < 4; ++m) _Pragma("unroll") for (int k = 0; k < 2; ++k) dst[m][k] = *(const PG8_LAS bf16x8*)(lds + PG8_SA(b, h) + aoff + m * 2048 + k * 1024); } while (0)
#define PG8_LDB(dst, b, h) do { _Pragma("unroll") for (int n = 0; n < 2; ++n) _Pragma("unroll") for (int k = 0; k < 2; ++k) dst[n][k] = *(const PG8_LAS bf16x8*)(lds + PG8_SB(b, h) + boff + n * 2048 + k * 1024); } while (0)
#define PG8_MMA(ai, bj, At, Bt) do { __builtin_amdgcn_s_setprio(1); _Pragma("unroll") for (int m = 0; m < 4; ++m) _Pragma("unroll") for (int n = 0; n < 2; ++n) _Pragma("unroll") for (int k = 0; k < 2; ++k) \
        acc[ai][bj][m][n] = __builtin_amdgcn_mfma_f32_16x16x32_bf16(Bt[n][k], At[m][k], acc[ai][bj][m][n], 0, 0, 0); __builtin_amdgcn_s_setprio(0); } while (0)
#define PG8_WAIT_V(n) asm volatile("s_waitcnt vmcnt(" #n ")" ::: "memory")
#define PG8_WAIT_L(n) asm volatile("s_waitcnt lgkmcnt(" #n ")" ::: "memory")
#define PG8_BAR __builtin_amdgcn_s_barrier()
#define PG8_SCHED __builtin_amdgcn_sched_barrier(0)
    Unit cur, nxt; int ui = 0;
    if (!S.next(0, cur)) return;
    f32x4 acc[2][2][4][2];
#pragma unroll
    for (int a = 0; a < 2; ++a)
#pragma unroll
        for (int b = 0; b < 2; ++b)
#pragma unroll
            for (int m = 0; m < 4; ++m)
#pragma unroll
                for (int n = 0; n < 2; ++n) acc[a][b][m][n] = (f32x4){0.f, 0.f, 0.f, 0.f};
    bf16x8 At[4][2], B0[2][2], B1[2][2];
    const char* cA = (const char*)g.A + (size_t)cur.pm * tstep + (size_t)cur.ko * 2; const char* cB = (const char*)g.Bt + (size_t)cur.pb * tstep + (size_t)cur.ko * 2;
    if constexpr (SP2) {
        PG8_STAGE(PG8_SB(0, 0), cB, voffB); PG8_STAGE(PG8_SB(0, 1), cB + hstep, voffB); PG8_STAGE(PG8_SA(0, 0), cA, voffA); PG8_STAGE(PG8_SA(0, 1), cA + hstep, voffA);
        if (wr == 1) PG8_BAR;
        PG8_WAIT_V(2); PG8_BAR;
        PG8_STAGE(PG8_SB(1, 0), cB + kstep, voffB); PG8_STAGE(PG8_SA(1, 0), cA + kstep, voffA); PG8_STAGE(PG8_SB(1, 1), cB + hstep + kstep, voffB);
        PG8_WAIT_V(6); PG8_BAR;
    } else {
        PG8_STAGE(PG8_SB(0, 0), cB, voffB); PG8_STAGE(PG8_SA(0, 0), cA, voffA); PG8_STAGE(PG8_SB(0, 1), cB + hstep, voffB); PG8_STAGE(PG8_SA(0, 1), cA + hstep, voffA);
        if (wr == 1) PG8_BAR;
        PG8_WAIT_V(4); PG8_BAR;
        PG8_STAGE(PG8_SB(1, 0), cB + kstep, voffB); PG8_STAGE(PG8_SA(1, 0), cA + kstep, voffA); PG8_STAGE(PG8_SB(1, 1), cB + hstep + kstep, voffB);
        PG8_WAIT_V(6); PG8_BAR;
    }
    for (;;) {
        const bool has_next = S.next(ui + 1, nxt);
        const char* nA = has_next ? (const char*)g.A + (size_t)nxt.pm * tstep + (size_t)nxt.ko * 2 : cA; const char* nB = has_next ? (const char*)g.Bt + (size_t)nxt.pb * tstep + (size_t)nxt.ko * 2 : cB;
#pragma nounroll
        for (int t = 0; t < nt; t += 2) {
            const bool last = (t == nt - 2);
            const char* a1 = cA + (size_t)(t + 1) * kstep;
            const char* a2 = last ? nA : cA + (size_t)(t + 2) * kstep; const char* b2 = last ? nB : cB + (size_t)(t + 2) * kstep;
            const char* a3 = a2 + kstep; const char* b3 = b2 + kstep;
            if constexpr (SP2) {
            PG8_LDB(B0, 0, 0); PG8_LDB(B1, 0, 1); PG8_SCHED; PG8_LDA(At, 0, 0); PG8_STAGE(PG8_SA(1, 1), a1 + hstep, voffA);
            PG8_WAIT_V(8); PG8_WAIT_L(0); PG8_BAR; PG8_MMA(0, 0, At, B0); PG8_MMA(0, 1, At, B1); PG8_BAR; PG8_SCHED;
            PG8_LDA(At, 0, 1); PG8_STAGE(PG8_SB(0, 0), b2, voffB); PG8_STAGE(PG8_SB(0, 1), b2 + hstep, voffB); PG8_STAGE(PG8_SA(0, 0), a2, voffA);
            PG8_WAIT_V(8); PG8_WAIT_L(0); PG8_BAR; PG8_MMA(1, 0, At, B0); PG8_MMA(1, 1, At, B1); PG8_BAR; PG8_SCHED;
            PG8_LDB(B0, 1, 0); PG8_LDB(B1, 1, 1); PG8_SCHED; PG8_LDA(At, 1, 0); PG8_STAGE(PG8_SA(0, 1), a2 + hstep, voffA);
            PG8_WAIT_V(8); PG8_WAIT_L(0); PG8_BAR; PG8_MMA(0, 0, At, B0); PG8_MMA(0, 1, At, B1); PG8_BAR; PG8_SCHED;
            PG8_LDA(At, 1, 1); PG8_STAGE(PG8_SB(1, 0), b3, voffB); PG8_STAGE(PG8_SB(1, 1), b3 + hstep, voffB); PG8_STAGE(PG8_SA(1, 0), a3, voffA);
            PG8_WAIT_V(8); PG8_WAIT_L(0); PG8_BAR; PG8_MMA(1, 0, At, B0); PG8_MMA(1, 1, At, B1); PG8_BAR; PG8_SCHED;
            } else {
            PG8_LDB(B0, 0, 0); PG8_SCHED; PG8_LDA(At, 0, 0); PG8_STAGE(PG8_SA(1, 1), a1 + hstep, voffA);
            PG8_WAIT_L(8); PG8_BAR; PG8_WAIT_L(0); PG8_MMA(0, 0, At, B0); PG8_BAR; PG8_SCHED;
            PG8_LDB(B1, 0, 1); PG8_STAGE(PG8_SB(0, 0), b2, voffB);
            PG8_BAR; PG8_WAIT_L(0); PG8_MMA(0, 1, At, B1); PG8_BAR;
            PG8_LDA(At, 0, 1); PG8_STAGE(PG8_SA(0, 0), a2, voffA);
            PG8_BAR; PG8_WAIT_L(0); PG8_MMA(1, 0, At, B0); PG8_BAR; PG8_SCHED;
            PG8_STAGE(PG8_SB(0, 1), b2 + hstep, voffB);
            PG8_WAIT_V(6); PG8_BAR; PG8_MMA(1, 1, At, B1); PG8_BAR;
            PG8_LDB(B0, 1, 0); PG8_SCHED; PG8_LDA(At, 1, 0); PG8_STAGE(PG8_SA(0, 1), a2 + hstep, voffA);
            PG8_WAIT_L(8); PG8_BAR; PG8_WAIT_L(0); PG8_MMA(0, 0, At, B0); PG8_BAR; PG8_SCHED;
            PG8_LDB(B1, 1, 1); PG8_STAGE(PG8_SB(1, 0), b3, voffB);
            PG8_BAR; PG8_WAIT_L(0); PG8_MMA(0, 1, At, B1); PG8_BAR;
            PG8_LDA(At, 1, 1); PG8_STAGE(PG8_SA(1, 0), a3, voffA);
            PG8_BAR; PG8_WAIT_L(0); PG8_MMA(1, 0, At, B0); PG8_BAR; PG8_SCHED;
            PG8_STAGE(PG8_SB(1, 1), b3 + hstep, voffB);
            PG8_WAIT_V(6); PG8_BAR; PG8_MMA(1, 1, At, B1); PG8_BAR;
            }
        }
        if constexpr (ALIGN_EPI) { if (wr == 0) PG8_BAR; }
        E(acc, cur, wr, wc, fr, fq);
        if (!has_next) break;
#pragma unroll
        for (int a = 0; a < 2; ++a)
#pragma unroll
            for (int b = 0; b < 2; ++b)
#pragma unroll
                for (int m = 0; m < 4; ++m)
#pragma unroll
                    for (int n = 0; n < 2; ++n) acc[a][b][m][n] = (f32x4){0.f, 0.f, 0.f, 0.f};
        cur = nxt; cA = nA; cB = nB; ++ui;
        if constexpr (ALIGN_EPI) { if (wr == 1) PG8_BAR; }
    }
    PG8_WAIT_V(0);
    if constexpr (!ALIGN_EPI) { if (wr == 0) PG8_BAR; }
    PG8_BAR;
#undef PG8_SA
#undef PG8_SB
#undef PG8_STAGE
#undef PG8_LDA
#undef PG8_LDB
#undef PG8_MMA
#undef PG8_WAIT_V
#undef PG8_WAIT_L
#undef PG8_BAR
#undef PG8_SCHED
}
template <int IMM> __device__ __forceinline__ void glds16s(const void* sbase, unsigned voff, unsigned lds_wave_base) { unsigned keep;
    asm volatile("s_mov_b32 %0, m0\n\ts_add_i32 m0, %3, %4\n\ts_nop 0\n\tglobal_load_lds_dwordx4 %1, %2\n\ts_mov_b32 m0, %0" : "=&s"(keep) : "v"(voff), "s"(sbase), "s"(lds_wave_base), "n"(IMM) : "memory", "scc"); }
typedef int i32x4 __attribute__((ext_vector_type(4))); typedef int i32x8 __attribute__((ext_vector_type(8)));
template <class Epi, class Sched, bool ALIGN_EPI = false, bool SP2 = false>
__device__ __forceinline__ void gemm_phase8(PG8_LAS unsigned char* lds, const Gemm g, const Sched& S, const Epi& E) {
    int tid_ = threadIdx.x; asm volatile("" : "+v"(tid_));
    const int tid = tid_, wid = __builtin_amdgcn_readfirstlane(tid >> 6), lane = tid & 63, wr = wid >> 2, wc = wid & 3, fr = lane & 15, fq = lane >> 4;
    const int K = g.K, nt = K / BK, LD = g.ld;
    unsigned voffA[2], voffB[2];
#pragma unroll
    for (int i = 0; i < 2; ++i) { int R, C; stage_rc(tid * 16 + i * 8192, R, C); const int Rb = Epi::PERM ? ((R & ~31) + perm32(R & 31)) : R;
        voffA[i] = (unsigned)(R * LD + C) * 2u; voffB[i] = (unsigned)(Rb * LD + C) * 2u; }
    const size_t kstep = (size_t)(BK * 2);
    const size_t hstep = (size_t)HALF * LD * 2;
    const size_t tstep = 2 * hstep;
    const unsigned ldsw = (unsigned)wid * 1024u; const unsigned ldswb = (unsigned)__builtin_amdgcn_readfirstlane((int)((unsigned)(size_t)lds + ldsw));
    const int aoff = lds_byte(wr * 64 + fr, fq * 8), boff = lds_byte(wc * 32 + fr, fq * 8);
#define PG8_SA(b, h) (((b) * 2 + (h)) * HTB)
#define PG8_SB(b, h) ((4 + (b) * 2 + (h)) * HTB)
#define PG8_STAGE(bufoff, gbase, voff) do { glds16s<(bufoff)>((const void*)(gbase), (voff)[0], ldswb); glds16s<(bufoff) + 8192>((const void*)(gbase), (voff)[1], ldswb); } while (0)
#define PG8_LDA(dst, b, h) do { _Pragma("unroll") for (int m = 0; m < 4; ++m) dst[m] = __builtin_shufflevector(*(const PG8_LAS i32x4*)(lds + PG8_SA(b, h) + aoff + m * 2048), *(const PG8_LAS i32x4*)(lds + PG8_SA(b, h) + aoff + m * 2048 + 1024), 0, 1, 2, 3, 4, 5, 6, 7); } while (0)
#define PG8_LDB(dst, b, h) do { _Pragma("unroll") for (int n = 0; n < 2; ++n) dst[n] = __builtin_shufflevector(*(const PG8_LAS i32x4*)(lds + PG8_SB(b, h) + boff + n * 2048), *(const PG8_LAS i32x4*)(lds + PG8_SB(b, h) + boff + n * 2048 + 1024), 0, 1, 2, 3, 4, 5, 6, 7); } while (0)
#define PG8_MMA(ai, bj, At, Bt) do { __builtin_amdgcn_s_setprio(1); _Pragma("unroll") for (int m = 0; m < 4; ++m) _Pragma("unroll") for (int n = 0; n < 2; ++n) \
        acc[ai][bj][m][n] = __builtin_amdgcn_mfma_scale_f32_16x16x128_f8f6f4(Bt[n], At[m], acc[ai][bj][m][n], 0, 0, 0, 0x7f7f7f7f, 0, 0x7f7f7f7f); __builtin_amdgcn_s_setprio(0); } while (0)
#define PG8_WAIT_V(n) asm volatile("s_waitcnt vmcnt(" #n ")" ::: "memory")
#define PG8_WAIT_L(n) asm volatile("s_waitcnt lgkmcnt(" #n ")" ::: "memory")
#define PG8_BAR __builtin_amdgcn_s_barrier()
#define PG8_SCHED __builtin_amdgcn_sched_barrier(0)
    Unit cur, nxt; int ui = 0;
    if (!S.next(0, cur)) return;
    f32x4 acc[2][2][4][2];
#pragma unroll
    for (int a = 0; a < 2; ++a)
#pragma unroll
        for (int b = 0; b < 2; ++b)
#pragma unroll
            for (int m = 0; m < 4; ++m)
#pragma unroll
                for (int n = 0; n < 2; ++n) acc[a][b][m][n] = (f32x4){0.f, 0.f, 0.f, 0.f};
    i32x8 At[4], B0[2], B1[2];
    const char* cA = (const char*)g.A + (size_t)cur.pm * tstep + (size_t)cur.ko * 2; const char* cB = (const char*)g.Bt + (size_t)cur.pb * tstep + (size_t)cur.ko * 2;
    if constexpr (SP2) {
        PG8_STAGE(PG8_SB(0, 0), cB, voffB); PG8_STAGE(PG8_SB(0, 1), cB + hstep, voffB); PG8_STAGE(PG8_SA(0, 0), cA, voffA); PG8_STAGE(PG8_SA(0, 1), cA + hstep, voffA);
        if (wr == 1) PG8_BAR;
        PG8_WAIT_V(2); PG8_BAR;
        PG8_STAGE(PG8_SB(1, 0), cB + kstep, voffB); PG8_STAGE(PG8_SA(1, 0), cA + kstep, voffA); PG8_STAGE(PG8_SB(1, 1), cB + hstep + kstep, voffB);
        PG8_WAIT_V(6); PG8_BAR;
    } else {
        PG8_STAGE(PG8_SB(0, 0), cB, voffB); PG8_STAGE(PG8_SA(0, 0), cA, voffA); PG8_STAGE(PG8_SB(0, 1), cB + hstep, voffB); PG8_STAGE(PG8_SA(0, 1), cA + hstep, voffA);
        if (wr == 1) PG8_BAR;
        PG8_WAIT_V(4); PG8_BAR;
        PG8_STAGE(PG8_SB(1, 0), cB + kstep, voffB); PG8_STAGE(PG8_SA(1, 0), cA + kstep, voffA); PG8_STAGE(PG8_SB(1, 1), cB + hstep + kstep, voffB);
        PG8_WAIT_V(6); PG8_BAR;
    }
    for (;;) {
        const bool has_next = S.next(ui + 1, nxt);
        const char* nA = has_next ? (const char*)g.A + (size_t)nxt.pm * tstep + (size_t)nxt.ko * 2 : cA; const char* nB = has_next ? (const char*)g.Bt + (size_t)nxt.pb * tstep + (size_t)nxt.ko * 2 : cB;
#pragma nounroll
        for (int t = 0; t < nt; t += 2) {
            const bool last = (t == nt - 2);
            const char* a1 = cA + (size_t)(t + 1) * kstep;
            const char* a2 = last ? nA : cA + (size_t)(t + 2) * kstep; const char* b2 = last ? nB : cB + (size_t)(t + 2) * kstep;
            const char* a3 = a2 + kstep; const char* b3 = b2 + kstep;
            if constexpr (SP2) {
            PG8_LDB(B0, 0, 0); PG8_LDB(B1, 0, 1); PG8_SCHED; PG8_LDA(At, 0, 0); PG8_STAGE(PG8_SA(1, 1), a1 + hstep, voffA);
            PG8_WAIT_V(8); PG8_WAIT_L(0); PG8_BAR; PG8_MMA(0, 0, At, B0); PG8_MMA(0, 1, At, B1); PG8_BAR; PG8_SCHED;
            PG8_LDA(At, 0, 1); PG8_STAGE(PG8_SB(0, 0), b2, voffB); PG8_STAGE(PG8_SB(0, 1), b2 + hstep, voffB); PG8_STAGE(PG8_SA(0, 0), a2, voffA);
            PG8_WAIT_V(8); PG8_WAIT_L(0); PG8_BAR; PG8_MMA(1, 0, At, B0); PG8_MMA(1, 1, At, B1); PG8_BAR; PG8_SCHED;
            PG8_LDB(B0, 1, 0); PG8_LDB(B1, 1, 1); PG8_SCHED; PG8_LDA(At, 1, 0); PG8_STAGE(PG8_SA(0, 1), a2 + hstep, voffA);
            PG8_WAIT_V(8); PG8_WAIT_L(0); PG8_BAR; PG8_MMA(0, 0, At, B0); PG8_MMA(0, 1, At, B1); PG8_BAR; PG8_SCHED;
            PG8_LDA(At, 1, 1); PG8_STAGE(PG8_SB(1, 0), b3, voffB); PG8_STAGE(PG8_SB(1, 1), b3 + hstep, voffB); PG8_STAGE(PG8_SA(1, 0), a3, voffA);
            PG8_WAIT_V(8); PG8_WAIT_L(0); PG8_BAR; PG8_MMA(1, 0, At, B0); PG8_MMA(1, 1, At, B1); PG8_BAR; PG8_SCHED;
            } else {
            PG8_LDB(B0, 0, 0); PG8_SCHED; PG8_LDA(At, 0, 0); PG8_STAGE(PG8_SA(1, 1), a1 + hstep, voffA);
            PG8_WAIT_L(8); PG8_BAR; PG8_WAIT_L(0); PG8_MMA(0, 0, At, B0); PG8_BAR; PG8_SCHED;
            PG8_LDB(B1, 0, 1); PG8_STAGE(PG8_SB(0, 0), b2, voffB);
            PG8_BAR; PG8_WAIT_L(0); PG8_MMA(0, 1, At, B1); PG8_BAR;
            PG8_LDA(At, 0, 1); PG8_STAGE(PG8_SA(0, 0), a2, voffA);
            PG8_BAR; PG8_WAIT_L(0); PG8_MMA(1, 0, At, B0); PG8_BAR; PG8_SCHED;
            PG8_STAGE(PG8_SB(0, 1), b2 + hstep, voffB);
            PG8_WAIT_V(6); PG8_BAR; PG8_MMA(1, 1, At, B1); PG8_BAR;
            PG8_LDB(B0, 1, 0); PG8_SCHED; PG8_LDA(At, 1, 0); PG8_STAGE(PG8_SA(0, 1), a2 + hstep, voffA);
            PG8_WAIT_L(8); PG8_BAR; PG8_WAIT_L(0); PG8_MMA(0, 0, At, B0); PG8_BAR; PG8_SCHED;
            PG8_LDB(B1, 1, 1); PG8_STAGE(PG8_SB(1, 0), b3, voffB);
            PG8_BAR; PG8_WAIT_L(0); PG8_MMA(0, 1, At, B1); PG8_BAR;
            PG8_LDA(At, 1, 1); PG8_STAGE(PG8_SA(1, 0), a3, voffA);
            PG8_BAR; PG8_WAIT_L(0); PG8_MMA(1, 0, At, B0); PG8_BAR; PG8_SCHED;
            PG8_STAGE(PG8_SB(1, 1), b3 + hstep, voffB);
            PG8_WAIT_V(6); PG8_BAR; PG8_MMA(1, 1, At, B1); PG8_BAR;
            }
        }
        if constexpr (ALIGN_EPI) { if (wr == 0) PG8_BAR; }
        { int l2_ = (int)threadIdx.x; asm volatile("" : "+v"(l2_)); E(acc, cur, wr, wc, l2_ & 15, (l2_ >> 4) & 3); }
        if (!has_next) break;
#pragma unroll
        for (int a = 0; a < 2; ++a)
#pragma unroll
            for (int b = 0; b < 2; ++b)
#pragma unroll
                for (int m = 0; m < 4; ++m)
#pragma unroll
                    for (int n = 0; n < 2; ++n) acc[a][b][m][n] = (f32x4){0.f, 0.f, 0.f, 0.f};
        cur = nxt; cA = nA; cB = nB; ++ui;
        if constexpr (ALIGN_EPI) { if (wr == 1) PG8_BAR; }
    }
    PG8_WAIT_V(0);
    if constexpr (!ALIGN_EPI) { if (wr == 0) PG8_BAR; }
    PG8_BAR;
#undef PG8_SA
#undef PG8_SB
#undef PG8_STAGE
#undef PG8_LDA
#undef PG8_LDB
#undef PG8_MMA
#undef PG8_WAIT_V
#undef PG8_WAIT_L
#undef PG8_BAR
#undef PG8_SCHED
}
}

#include <hip/hip_bf16.h>
#include <cmath>
namespace attn_body {
using bf16=__hip_bfloat16;
using bf16x8=__attribute__((ext_vector_type(8)))short;
using s16x4=__attribute__((ext_vector_type(4)))short;
using f32x16=__attribute__((ext_vector_type(16)))float;
using u32x4=__attribute__((ext_vector_type(4)))unsigned;
constexpr int SEQ=4096,D=64,DM=1024,ODM=2048;
constexpr int NW=8,QBLK=32,QB=QBLK*NW,KVBLK=64,NQB=SEQ/QB;
__device__ __forceinline__ int crow(int r,int hi){return (r&3)+8*(r>>2)+4*hi;}
#define SBAR() __builtin_amdgcn_sched_barrier(0)
__device__ __forceinline__ void cmask(f32x16&p0,f32x16&p1,int jb,int qrel,int hi){
  const float NEG=-INFINITY; int kb=64*jb+4*hi;
  #pragma unroll
  for(int r=0;r<16;++r){int kv=kb+(r&3)+8*(r>>2); if(kv>qrel)p0[r]=NEG; if(kv+32>qrel)p1[r]=NEG;}
}

constexpr int NSLOT=3, SLOTB=8192;
constexpr int LDS_K=0, LDS_V=NSLOT*SLOTB, LDS_WS=3*NSLOT*SLOTB, LDS_OST=LDS_WS+NW*64*4, LDS_BYTES=LDS_OST+NW*4096;
constexpr float C2=0.125f*1.4426950408889634f;
__device__ __forceinline__ void glds16(const void*gsrc,unsigned lds_dst){unsigned keep;
  asm volatile("s_mov_b32 %0, m0\n\ts_mov_b32 m0, %2\n\ts_nop 0\n\tglobal_load_lds_dwordx4 %1, off\n\ts_mov_b32 m0, %0":"=&s"(keep):"v"(gsrc),"s"(lds_dst):"memory");}
__device__ __forceinline__ float max3f(float a,float b,float c){float r;asm("v_max3_f32 %0, %1, %2, %3":"=v"(r):"v"(a),"v"(b),"v"(c));return r;}
__device__ __forceinline__ float max2f(float a,float b){float r;asm("v_max_f32_e32 %0, %1, %2":"=v"(r):"v"(a),"v"(b));return r;}
__device__ __forceinline__ float fadd_s(float a,float b){float r;asm("v_add_f32_e32 %0, %1, %2":"=v"(r):"v"(a),"v"(b));return r;}
__device__ __forceinline__ float fsub_s(float a,float b){float r;asm("v_sub_f32_e32 %0, %1, %2":"=v"(r):"v"(a),"v"(b));return r;}
typedef float f32x2_t __attribute__((ext_vector_type(2))); typedef __bf16 bf16x2_t __attribute__((ext_vector_type(2)));
__device__ __forceinline__ unsigned cvtpk_s(float lo,float hi){f32x2_t v={lo,hi};bf16x2_t b=__builtin_convertvector(v,bf16x2_t);return __builtin_bit_cast(unsigned,b);}
#define WAIT_BAR(N) asm volatile("s_waitcnt vmcnt(" #N ") lgkmcnt(0)\n\ts_barrier":::"memory")

__device__ __forceinline__ void qkt(f32x16&p0,f32x16&p1,const char*Kslot,__attribute__((address_space(3))) const char*qp,const f32x16&negm,int r32,int hi){
  const char*kb=Kslot+hi*1024+r32*16;
  #pragma unroll
  for(int d0=0;d0<4;++d0){
    const bf16x8 b0=*reinterpret_cast<const bf16x8*>(kb+d0*2048);
    const bf16x8 b1=*reinterpret_cast<const bf16x8*>(kb+d0*2048+512);
    const bf16x8 qf=*(const __attribute__((address_space(3))) bf16x8*)(qp+d0*1024);
    if(d0==0){p0=__builtin_amdgcn_mfma_f32_32x32x16_bf16(b0,qf,negm,0,0,0);p1=__builtin_amdgcn_mfma_f32_32x32x16_bf16(b1,qf,negm,0,0,0);}
    else{p0=__builtin_amdgcn_mfma_f32_32x32x16_bf16(b0,qf,p0,0,0,0);p1=__builtin_amdgcn_mfma_f32_32x32x16_bf16(b1,qf,p1,0,0,0);}}
}
typedef __attribute__((address_space(3))) const char* lds_cptr;
typedef short v4i16_t __attribute__((ext_vector_type(4)));
__device__ __forceinline__ void kload8(bf16x8*kf,lds_cptr kp){
  kf[0]=*(const __attribute__((address_space(3))) bf16x8*)(kp);      kf[1]=*(const __attribute__((address_space(3))) bf16x8*)(kp+512);
  kf[2]=*(const __attribute__((address_space(3))) bf16x8*)(kp+2048); kf[3]=*(const __attribute__((address_space(3))) bf16x8*)(kp+2560);
  kf[4]=*(const __attribute__((address_space(3))) bf16x8*)(kp+4096); kf[5]=*(const __attribute__((address_space(3))) bf16x8*)(kp+4608);
  kf[6]=*(const __attribute__((address_space(3))) bf16x8*)(kp+6144); kf[7]=*(const __attribute__((address_space(3))) bf16x8*)(kp+6656);
}
__device__ __forceinline__ void kload2(bf16x8*kf,lds_cptr kp,int j){ kf[2*j]=*(const __attribute__((address_space(3))) bf16x8*)(kp+j*2048); kf[2*j+1]=*(const __attribute__((address_space(3))) bf16x8*)(kp+j*2048+512); }
__device__ __forceinline__ s16x4 vtr(lds_cptr p){ return __builtin_bit_cast(s16x4,__builtin_amdgcn_ds_read_tr16_b64_v4i16((__attribute__((address_space(3))) v4i16_t*)p)); }
__device__ __forceinline__ float rowmax(const f32x16&p0,const f32x16&p1){
  float a=max3f(p0[0],p0[1],p1[0]),b=max3f(p0[2],p0[3],p1[1]);a=max3f(a,p1[2],p1[3]);
  #pragma unroll
  for(int r=4;r<16;r+=4){a=max3f(a,p0[r],p0[r+1]);b=max3f(b,p0[r+2],p0[r+3]);a=max3f(a,p1[r],p1[r+1]);b=max3f(b,p1[r+2],p1[r+3]);}
  const float m=max2f(a,b);
  auto rr=__builtin_amdgcn_permlane32_swap(__float_as_uint(m),__float_as_uint(m),false,false);
  return max2f(__uint_as_float(rr[0]),__uint_as_float(rr[1]));
}
__device__ __forceinline__ void pv(f32x16*o,int vb,bf16x8 pa0,bf16x8 pa1,bf16x8 pa2,bf16x8 pa3){
  #pragma unroll
  for(int d0=0;d0<2;++d0){s16x4 lo[4],hi[4];
    #pragma unroll
    for(int ks=0;ks<4;++ks){
      asm volatile("ds_read_b64_tr_b16 %0,%1 offset:%c2":"=&v"(lo[ks]):"v"(vb),"i"(d0*4096+ks*1024):"memory");
      asm volatile("ds_read_b64_tr_b16 %0,%1 offset:%c2":"=&v"(hi[ks]):"v"(vb),"i"(d0*4096+ks*1024+512):"memory");}
    asm volatile("s_waitcnt lgkmcnt(0)":::"memory");SBAR();
    #define PK(k) (bf16x8){lo[k][0],lo[k][1],lo[k][2],lo[k][3],hi[k][0],hi[k][1],hi[k][2],hi[k][3]}
    o[d0]=__builtin_amdgcn_mfma_f32_32x32x16_bf16(pa0,PK(0),o[d0],0,0,0);
    o[d0]=__builtin_amdgcn_mfma_f32_32x32x16_bf16(pa1,PK(1),o[d0],0,0,0);
    o[d0]=__builtin_amdgcn_mfma_f32_32x32x16_bf16(pa2,PK(2),o[d0],0,0,0);
    o[d0]=__builtin_amdgcn_mfma_f32_32x32x16_bf16(pa3,PK(3),o[d0],0,0,0);
    #undef PK
  }
}

#ifndef ATTN_STORE16
#define ATTN_STORE16(p,v) (*(u32x4*)(p)=(v))
#endif
template<int THRL> __device__ __forceinline__ void attn_unit(int qb,const bf16*Q,const bf16*__restrict__ K,const bf16*__restrict__ V,bf16*O,char*shm){
  const int tid=threadIdx.x,lane=tid&63,r32=lane&31,hi=lane>>5; const int wid=__builtin_amdgcn_readfirstlane(tid>>6);
  const int q0=qb*QB;
  const bf16*Qw=Q+(long)(q0+wid*QBLK)*DM;
  const bf16*Kh=K,*Vh=V;
  const unsigned lds0=(unsigned)(uintptr_t)shm;
  float*wsf=(float*)(shm+LDS_WS)+wid*64;
  const bf16*ksrc=Kh+(long)lane*DM+wid*8;
  const bf16*vsrc=Vh+(long)(16*(wid&3)+(lane>>2))*DM+(wid>>2)*32+(lane&3)*8;
  const unsigned kdst=lds0+LDS_K+wid*1024, vdst=lds0+LDS_V+wid*1024;
  #define DMA_K(t,slot) glds16(ksrc+(long)(t)*KVBLK*DM,(unsigned)__builtin_amdgcn_readfirstlane(kdst+(slot)))
  #define DMA_V(t,slot) do{ glds16(vsrc+(long)(t)*KVBLK*DM,(unsigned)__builtin_amdgcn_readfirstlane(vdst+2*(slot))); glds16(vsrc+(long)(t)*KVBLK*DM+64,(unsigned)__builtin_amdgcn_readfirstlane(vdst+2*(slot)+8192)); }while(0)
  const int vb0=(int)(lds0+LDS_V)+((lane>>4)&1)*32+(lane&3)*8+(4*hi+((lane&15)>>2))*64;
  const char*Kbase=shm+LDS_K; bf16x8 kf[8];
  const lds_cptr shm3=(lds_cptr)shm; const lds_cptr kp0=shm3+LDS_K+hi*1024+r32*16; const lds_cptr vp0=shm3+LDS_V+((lane>>4)&1)*32+(lane&3)*8+(4*hi+((lane&15)>>2))*64;
  const int NT=(q0+QB)/KVBLK;
  DMA_K(0,0);DMA_V(0,0);DMA_K(1,SLOTB);
  const lds_cptr qp0=(lds_cptr)shm+LDS_OST+wid*4096+(hi*32+r32)*16;
  { bf16x8 qr[4];
  #pragma unroll
  for(int d0=0;d0<4;++d0)qr[d0]=*reinterpret_cast<const bf16x8*>(&Qw[(long)r32*DM+d0*16+hi*8]);
  #pragma unroll
  for(int d0=0;d0<4;++d0)*(__attribute__((address_space(3))) bf16x8*)((__attribute__((address_space(3))) char*)qp0+d0*1024)=qr[d0]; }
  float mhat=0.f,l_reg=0.f;f32x16 o[4];o[0]=f32x16{};o[1]=f32x16{};o[2]=f32x16{};o[3]=f32x16{};f32x16 negm=f32x16{};asm volatile("":"+v"(negm));
  const int qrel=wid*QBLK+r32;
  #define CMASK(P0,P1,t) do{int jb_=(t)-(NT-4); if(jb_>=0)cmask(P0,P1,jb_,qrel,hi);}while(0)
  bool resc=false;
  #define START(P0,P1) do{ const float rm=rowmax(P0,P1); resc=false; \
    { const float dl=rm; mhat=fadd_s(mhat,dl); \
      _Pragma("unroll") for(int r=0;r<16;++r){P0[r]=fsub_s(P0[r],dl);P1[r]=fsub_s(P1[r],dl);} \
      _Pragma("unroll") for(int r=0;r<16;++r)negm[r]=-mhat; asm volatile("":"+v"(negm)); } \
    _Pragma("unroll") for(int r=0;r<16;++r)P0[r]=__builtin_amdgcn_exp2f(P0[r]); }while(0)
  #define RESC() do{ if(resc){ asm volatile("s_waitcnt lgkmcnt(0)":::"memory"); \
      _Pragma("unroll") for(int d_=0;d_<4;++d_) _Pragma("unroll") for(int r=0;r<16;++r)o[d_][r]*=wsf[crow(r,hi)]; } }while(0)
  f32x16 pA0,pA1,pB0,pB1;
  int sl_prev=0,sl_cur=0,sl_next=SLOTB;
  #define ROT() do{sl_prev=sl_cur;sl_cur=sl_next;sl_next=(sl_next==(NSLOT-1)*SLOTB)?0:sl_next+SLOTB;}while(0)
  DMA_K(2,2*SLOTB);
  WAIT_BAR(4);
  qkt(pA0,pA1,Kbase,qp0,negm,r32,hi);asm volatile("s_nop 15\n\ts_nop 7":"+v"(pA0),"+v"(pA1));CMASK(pA0,pA1,0);
  START(pA0,pA1);
  _Pragma("unroll") for(int r=0;r<16;++r)pA1[r]=__builtin_amdgcn_exp2f(pA1[r]);
  WAIT_BAR(0);
  DMA_K(3,0);DMA_V(1,SLOTB);
  ROT();
  kload8(kf,kp0+sl_cur);
  WAIT_BAR(3);
  s16x4 vlo[8],vhi[8]; u32x4 pw0,pw1,pw2,pw3;
  #define PKW(P,B) cvtpk_s(P[B],P[B+1])
  #define PAF(k) __builtin_bit_cast(bf16x8,pw##k)
  #define VFR(i) (bf16x8){vlo[i][0],vlo[i][1],vlo[i][2],vlo[i][3],vhi[i][0],vhi[i][1],vhi[i][2],vhi[i][3]}
  #define PIN(x) asm volatile("":"+v"(x))
  #define MX3(a,b,c) __builtin_fmaxf(__builtin_fmaxf((a),(b)),(c))
  #define GAPA(MF,A0,A1,A2,A3,W0,W1,PW) do{ MF; sacc+=A0; sacc+=A1; sacc+=A2; sacc+=A3; PIN(sacc); W0; W1; PIN(PW); SBAR(); }while(0)
  #define EX(v) __builtin_amdgcn_exp2f(v)
  #define GAPB(MF,X,B) do{ MF; X[B]=EX(X[B]); X[B+1]=EX(X[B+1]); PIN(X); SBAR(); }while(0)
  #define VRD(i) do{ vlo[i]=vtr(vp_+(((i)>>2)*4096+((i)&3)*1024)); vhi[i]=vtr(vp_+(((i)>>2)*4096+((i)&3)*1024+512)); }while(0)
  #define QF(d) (*(const __attribute__((address_space(3))) bf16x8*)(qp0+(d)*1024))
  #define VRD2(i) do{ vlo[i]=vtr(vp_+(8192+((i)>>2)*4096+((i)&3)*1024)); vhi[i]=vtr(vp_+(8192+((i)>>2)*4096+((i)&3)*1024+512)); }while(0)
  #define KRD(G,j) do{ if(G){ kload2(kf,kp0+sl_next,j); SBAR(); } }while(0)
  #define STEP(C0,C1,P0,P1,t,GK,GV,GL) do{ SBAR(); \
    const lds_cptr vp_=vp0+2*sl_prev; \
    VRD(0); const bf16x8 q1_=QF(1); SBAR(); float sacc=(P0[0]+P0[1]); \
    GAPA(C0=__builtin_amdgcn_mfma_f32_32x32x16_bf16(kf[0],qn_,negm,0,0,0), P0[2],P0[3],P0[4],P0[5],     pw0[0]=PKW(P0,0), pw0[1]=PKW(P0,2), pw0); \
    VRD(4); SBAR(); GAPA(C1=__builtin_amdgcn_mfma_f32_32x32x16_bf16(kf[1],qn_,negm,0,0,0), P0[6],P0[7],P0[8],P0[9],     pw0[2]=PKW(P0,4), pw0[3]=PKW(P0,6), pw0); \
    VRD(1); const bf16x8 q2_=QF(2); SBAR(); GAPA(C0=__builtin_amdgcn_mfma_f32_32x32x16_bf16(kf[2],q1_,C0,0,0,0),   P0[10],P0[11],P0[12],P0[13], pw1[0]=PKW(P0,8), pw1[1]=PKW(P0,10), pw1); \
    VRD(5); SBAR(); GAPA(C1=__builtin_amdgcn_mfma_f32_32x32x16_bf16(kf[3],q1_,C1,0,0,0),   P0[14],P0[15],P1[0],P1[1],   pw1[2]=PKW(P0,12),pw1[3]=PKW(P0,14), pw1); \
    VRD(2); const bf16x8 q3_=QF(3); SBAR(); GAPA(C0=__builtin_amdgcn_mfma_f32_32x32x16_bf16(kf[4],q2_,C0,0,0,0),   P1[2],P1[3],P1[4],P1[5],     pw2[0]=PKW(P1,0), pw2[1]=PKW(P1,2), pw2); \
    VRD(6); SBAR(); GAPA(C1=__builtin_amdgcn_mfma_f32_32x32x16_bf16(kf[5],q2_,C1,0,0,0),   P1[6],P1[7],P1[8],P1[9],     pw2[2]=PKW(P1,4), pw2[3]=PKW(P1,6), pw2); \
    VRD(3); SBAR(); GAPA(C0=__builtin_amdgcn_mfma_f32_32x32x16_bf16(kf[6],q3_,C0,0,0,0),   P1[10],P1[11],P1[12],P1[13], pw3[0]=PKW(P1,8), pw3[1]=PKW(P1,10), pw3); \
    VRD(7); SBAR(); GAPA(C1=__builtin_amdgcn_mfma_f32_32x32x16_bf16(kf[7],q3_,C1,0,0,0),   P1[14],P1[15],0.f,0.f,       pw3[2]=PKW(P1,12),pw3[3]=PKW(P1,14), pw3); \
    l_reg+=sacc; \
    if(GK){DMA_K((t)+3,sl_cur);} if(GV){DMA_V((t)+1,sl_next);} \
    CMASK(C0,C1,t); \
    { float a=MX3(C0[0],C0[1],C1[0]),b=MX3(C0[2],C0[3],C1[1]); a=MX3(a,C1[2],C1[3]); \
      _Pragma("unroll") for(int r=4;r<16;r+=4){a=MX3(a,C0[r],C0[r+1]);b=MX3(b,C0[r+2],C0[r+3]);a=MX3(a,C1[r],C1[r+1]);b=MX3(b,C1[r+2],C1[r+3]);} \
      float rm=__builtin_fmaxf(a,b); { auto rr=__builtin_amdgcn_permlane32_swap(__float_as_uint(rm),__float_as_uint(rm),false,false); rm=__builtin_fmaxf(__uint_as_float(rr[0]),__uint_as_float(rr[1])); } \
      resc=false; \
      if(__builtin_expect(__any(rm>(float)THRL),0)){ const float dl=__builtin_fmaxf(rm,0.f); mhat+=dl; \
        _Pragma("unroll") for(int r=0;r<16;++r){C0[r]-=dl;C1[r]-=dl;} \
        _Pragma("unroll") for(int r=0;r<16;++r)negm[r]=-mhat; asm volatile("":"+v"(negm)); \
        const float f=__builtin_amdgcn_exp2f(-dl); l_reg*=f; if(hi==0)wsf[r32]=f; resc=true; } } \
    SBAR(); \
    GAPB(o[0]=__builtin_amdgcn_mfma_f32_32x32x16_bf16(PAF(0),VFR(0),o[0],0,0,0), C0,0); \
    GAPB(o[1]=__builtin_amdgcn_mfma_f32_32x32x16_bf16(PAF(0),VFR(4),o[1],0,0,0), C0,2); \
    KRD(GL,0); GAPB(o[0]=__builtin_amdgcn_mfma_f32_32x32x16_bf16(PAF(1),VFR(1),o[0],0,0,0), C0,4); \
    KRD(GL,1); GAPB(o[1]=__builtin_amdgcn_mfma_f32_32x32x16_bf16(PAF(1),VFR(5),o[1],0,0,0), C0,6); \
    KRD(GL,2); GAPB(o[0]=__builtin_amdgcn_mfma_f32_32x32x16_bf16(PAF(2),VFR(2),o[0],0,0,0), C0,8); \
    KRD(GL,3); GAPB(o[1]=__builtin_amdgcn_mfma_f32_32x32x16_bf16(PAF(2),VFR(6),o[1],0,0,0), C0,10); \
    GAPB(o[0]=__builtin_amdgcn_mfma_f32_32x32x16_bf16(PAF(3),VFR(3),o[0],0,0,0), C0,12); \
    GAPB(o[1]=__builtin_amdgcn_mfma_f32_32x32x16_bf16(PAF(3),VFR(7),o[1],0,0,0), C0,14); \
      \
    VRD2(0); VRD2(4); SBAR(); \
    VRD2(1); VRD2(5); SBAR(); GAPB(o[2]=__builtin_amdgcn_mfma_f32_32x32x16_bf16(PAF(0),VFR(0),o[2],0,0,0), C1,0); GAPB(o[3]=__builtin_amdgcn_mfma_f32_32x32x16_bf16(PAF(0),VFR(4),o[3],0,0,0), C1,2); \
    VRD2(2); VRD2(6); SBAR(); GAPB(o[2]=__builtin_amdgcn_mfma_f32_32x32x16_bf16(PAF(1),VFR(1),o[2],0,0,0), C1,4); GAPB(o[3]=__builtin_amdgcn_mfma_f32_32x32x16_bf16(PAF(1),VFR(5),o[3],0,0,0), C1,6); \
    VRD2(3); VRD2(7); SBAR(); GAPB(o[2]=__builtin_amdgcn_mfma_f32_32x32x16_bf16(PAF(2),VFR(2),o[2],0,0,0), C1,8); GAPB(o[3]=__builtin_amdgcn_mfma_f32_32x32x16_bf16(PAF(2),VFR(6),o[3],0,0,0), C1,10); \
    qn_=QF(0); GAPB(o[2]=__builtin_amdgcn_mfma_f32_32x32x16_bf16(PAF(3),VFR(3),o[2],0,0,0), C1,12); GAPB(o[3]=__builtin_amdgcn_mfma_f32_32x32x16_bf16(PAF(3),VFR(7),o[3],0,0,0), C1,14); \
    }while(0)
  bf16x8 qn_=QF(0);
  int t=1;
  #undef CMASK
  #define CMASK(P0,P1,t) do{}while(0)
  for(;t+5<NT;t+=2){
    STEP(pB0,pB1,pA0,pA1,t,true,true,true);     WAIT_BAR(3); RESC(); ROT();
    STEP(pA0,pA1,pB0,pB1,t+1,true,true,true);   WAIT_BAR(3); RESC(); ROT();
  }
  #undef CMASK
  #define CMASK(P0,P1,t) do{int jb_=(t)-(NT-4); if(jb_>=0)cmask(P0,P1,jb_,qrel,hi);}while(0)
  #define ENDW(tt) do{ if((tt)+3<NT){WAIT_BAR(3);} else if((tt)+2<NT){WAIT_BAR(2);} else {WAIT_BAR(0);} }while(0)
  for(;t+1<NT;t+=2){
    STEP(pB0,pB1,pA0,pA1,t,(t+3<NT),(t+1<NT),(t+1<NT));       ENDW(t);   RESC(); ROT();
    STEP(pA0,pA1,pB0,pB1,t+1,(t+4<NT),(t+2<NT),(t+2<NT));     ENDW(t+1); RESC(); ROT();
  }
  STEP(pB0,pB1,pA0,pA1,NT-1,false,false,false); RESC();
  { float sacc=pB0[0]+pB0[1]; _Pragma("unroll") for(int r=2;r<16;++r)sacc+=pB0[r]; _Pragma("unroll") for(int r=0;r<16;++r)sacc+=pB1[r]; l_reg+=sacc;
    pw0=(u32x4){PKW(pB0,0),PKW(pB0,2),PKW(pB0,4),PKW(pB0,6)};pw1=(u32x4){PKW(pB0,8),PKW(pB0,10),PKW(pB0,12),PKW(pB0,14)};pw2=(u32x4){PKW(pB1,0),PKW(pB1,2),PKW(pB1,4),PKW(pB1,6)};pw3=(u32x4){PKW(pB1,8),PKW(pB1,10),PKW(pB1,12),PKW(pB1,14)};
    SBAR(); pv(o,vb0+2*sl_cur,PAF(0),PAF(1),PAF(2),PAF(3)); pv(o+2,vb0+2*sl_cur+8192,PAF(0),PAF(1),PAF(2),PAF(3)); }
  #undef PKW
  #undef PAF
  #undef VFR
  #undef PIN
  #undef MX3
  #undef GAPA
  #undef GAPB
  #undef EX
  #undef VRD
  #undef VRD2
  #undef QF
  #undef KRD
  #undef STEP
  #undef ENDW
  {auto rr=__builtin_amdgcn_permlane32_swap(__float_as_uint(l_reg),__float_as_uint(l_reg),false,false);l_reg=__uint_as_float(rr[0])+__uint_as_float(rr[1]);}
  if(hi==0)wsf[32+r32]=l_reg;asm volatile("s_waitcnt lgkmcnt(0)":::"memory");
  float rli[16];
  #pragma unroll
  for(int r=0;r<16;++r)rli[r]=__builtin_amdgcn_rcpf(wsf[32+crow(r,hi)]);
  bf16*Ow=O+(long)(q0+wid*QBLK)*ODM;
  { bf16*stg=(bf16*)(shm+LDS_OST)+wid*2048;
    #pragma unroll
    for(int hv=0;hv<2;++hv){
      #pragma unroll
      for(int r=0;r<16;++r){const int orow=crow(r,hi);
        #pragma unroll
        for(int d0=0;d0<2;++d0)stg[orow*64+d0*32+r32]=__float2bfloat16(o[2*hv+d0][r]*rli[r]);}
      asm volatile("s_waitcnt lgkmcnt(0)":::"memory");
      #pragma unroll
      for(int i=0;i<4;++i){const int row=i*8+(lane>>3),ch=lane&7; const u32x4 v=*(const u32x4*)(stg+row*64+ch*8); ATTN_STORE16(Ow+(long)row*ODM+hv*64+ch*8,v);}
      asm volatile("s_waitcnt lgkmcnt(0)":::"memory"); } }
  asm volatile("s_waitcnt lgkmcnt(0)\n\ts_barrier":::"memory");
  #undef DMA_K
  #undef DMA_V
  #undef CMASK
  #undef START
  #undef RESC
  #undef ROT
}
constexpr int ATTN_LDS_BYTES=LDS_BYTES;
struct AttnTensors { const bf16* Q; const bf16* K; const bf16* V; bf16* O; };
template<int THRL=8> __device__ __forceinline__ void attn_phase(char*lds,const AttnTensors&T,int vcu,int G){
  for(int i=0;;++i){
    int combo,qb;
    if(G==256){ if(i>=4)break; combo=vcu>>2; const int s_=vcu&3; qb=(i==0)?s_:(i==1)?15-s_:(i==2)?4+s_:11-s_; }
    else { const int idx=i*G+vcu; if(idx>=1024)break; combo=idx&63; qb=15-(idx>>6); }
    const int b=combo>>4, hc=combo&15;
    const long r0=(long)b*SEQ;
    attn_unit<THRL>(qb, T.Q+r0*DM+hc*64, T.K+r0*DM+hc*64, T.V+r0*DM+(hc>>1)*128, T.O+r0*ODM+hc*128, lds);
  }
}
#undef SBAR
#undef WAIT_BAR
}

#define GAS __attribute__((address_space(1)))
#define LAS __attribute__((address_space(3)))
typedef unsigned short bf16;
typedef unsigned v4u __attribute__((ext_vector_type(4)));
typedef float f32x4 __attribute__((ext_vector_type(4)));
typedef short bf16x8 __attribute__((ext_vector_type(8)));
typedef GAS unsigned gu32;
typedef GAS unsigned long long gu64;
#define RLX_AGENT __ATOMIC_RELAXED, __HIP_MEMORY_SCOPE_AGENT
#define LDS_WAIT() asm volatile("s_waitcnt lgkmcnt(0)" ::: "memory")
#define VM_WAIT() asm volatile("s_waitcnt vmcnt(0)" ::: "memory")
__device__ __forceinline__ unsigned long long rt() { return __builtin_amdgcn_s_memrealtime(); }
__device__ __forceinline__ unsigned f2bf(float f) { unsigned u = __builtin_bit_cast(unsigned, f); return (u + 0x7fffu + ((u >> 16) & 1u)) >> 16; }
__device__ __forceinline__ unsigned pk2(float lo, float hi) { return f2bf(lo) | (f2bf(hi) << 16); }

#define XB_TMO      128
#define XB_XCNT(j)  (256  + 64 * (j))
#define XB_XSUB(j)  (1280 + 64 * (j))
#define XB_XGEN(j)  (2304 + 64 * (j))
#define XB_TOP      3328
#define XB_TOPGEN   3392
#define XCD_BAR_WORDS 3456
#define XB_SPIN_CAP (1u << 18)

__device__ __forceinline__ unsigned xb_ld(unsigned* p)              { return __hip_atomic_load(p, __ATOMIC_RELAXED, __HIP_MEMORY_SCOPE_AGENT); }
__device__ __forceinline__ unsigned xb_add(unsigned* p, unsigned v) { return __hip_atomic_fetch_add(p, v, __ATOMIC_RELAXED, __HIP_MEMORY_SCOPE_AGENT); }
__device__ __forceinline__ unsigned xb_xcc_id() { return (unsigned)__builtin_amdgcn_s_getreg((3 << 11) | 20) & 0xFu; }
#define XB_SPIN(cond, bar) do { unsigned _sp = 0; while (cond) { __builtin_amdgcn_s_sleep(1); \
    if ((++_sp & 255u) == 0u) { if (xb_ld(&(bar)[XB_TMO])) break; if (_sp > XB_SPIN_CAP) { atomicAdd(&(bar)[XB_TMO], 1u); break; } } } } while (0)

struct XcdBarrier {
    unsigned* bar; unsigned x;
    volatile LAS unsigned* st;
};

__device__ __forceinline__ XcdBarrier xcd_barrier_post(unsigned* bar, volatile LAS unsigned* st) {
    XcdBarrier b; b.bar = bar; b.x = xb_xcc_id(); b.st = st;
    if (threadIdx.x == 0) (void)xb_add(&bar[XB_XCNT(b.x)], 1u);
    return b;
}
__device__ __forceinline__ void xcd_barrier_complete(unsigned* bar, unsigned x, unsigned& nloc, unsigned& nx) {
    const unsigned G = gridDim.x * gridDim.y * gridDim.z;
    unsigned sum, cnt, mine, sp = 0u;
    for (;;) {
        sum = 0u; cnt = 0u; mine = 0u;
#pragma unroll
        for (unsigned j = 0; j < 16; ++j) { const unsigned c = xb_ld(&bar[XB_XCNT(j)]); sum += c; cnt += (c > 0u) ? 1u : 0u; mine = (j == x) ? c : mine; }
        if (sum == G) break;
        __builtin_amdgcn_s_sleep(1);
        if ((++sp & 255u) == 0u) { if (xb_ld(&bar[XB_TMO])) break; if (sp > XB_SPIN_CAP) { atomicAdd(&bar[XB_TMO], 1u); break; } }
    }
    nloc = mine > 0u ? mine : 1u; nx = cnt > 0u ? cnt : 1u;
}

__device__ __forceinline__ void xcd_barrier(const XcdBarrier& b) {
    asm volatile("s_waitcnt vmcnt(0)" ::: "memory");
    __syncthreads();
    if (threadIdx.x == 0) {
        unsigned* bar = b.bar;
        __builtin_amdgcn_s_waitcnt(0);
        unsigned nloc = b.st[0], nx = b.st[1];
        if (nloc == 0u) { xcd_barrier_complete(bar, b.x, nloc, nx); b.st[0] = nloc; b.st[1] = nx; }
        const unsigned old = xb_add(&bar[XB_XSUB(b.x)], 1u);
        const unsigned gen = old / nloc;
        if (old + 1u == (gen + 1u) * nloc) {
            __builtin_amdgcn_fence(__ATOMIC_RELEASE, "agent");
            asm volatile("s_waitcnt vmcnt(0)" ::: "memory");
            const unsigned og = xb_add(&bar[XB_TOP], 1u);
            const unsigned tg = og / nx;
            if (og + 1u == (tg + 1u) * nx) xb_add(&bar[XB_TOPGEN], 1u);
            else XB_SPIN(xb_ld(&bar[XB_TOPGEN]) == tg, bar);
            __builtin_amdgcn_fence(__ATOMIC_ACQUIRE, "agent");
            xb_add(&bar[XB_XGEN(b.x)], 1u);
            asm volatile("s_waitcnt vmcnt(0)" ::: "memory");
        } else {
            XB_SPIN(xb_ld(&bar[XB_XGEN(b.x)]) == gen, bar);
            __builtin_amdgcn_fence(__ATOMIC_ACQUIRE, "agent");
            asm volatile("s_waitcnt vmcnt(0)" ::: "memory");
        }
    }
    __syncthreads();
}

constexpr int NWAVES = 8;
constexpr int T_ = 16384, SEQL = 4096, DMODEL = 2048, NINP = 10752, NIN_SRC = 10688;
constexpr int RWW = 3584;
constexpr int NEXP = 32, DEXP = 1024, MAXROWS = 40960, MAXTILES = 160;
constexpr size_t MiB = 1u << 20;
constexpr size_t WS_CTL = 0, CTL_ZERO_BYTES = 1 * MiB;
constexpr size_t WS_ROPE = 1 * MiB;
constexpr size_t WS_BON = 2 * MiB;
constexpr size_t WS_ASG_E = 3 * MiB, WS_ASG_POS = WS_ASG_E + 256 * 1024, WS_ASG_GATE = WS_ASG_POS + 256 * 1024, WS_TOKDEST = WS_ASG_GATE + 256 * 1024;
constexpr size_t WS_ROWGATE = 4 * MiB;
constexpr size_t WS_CNTT = 5 * MiB;
constexpr size_t WS_RSTD = 5 * MiB + 64 * 1024;
constexpr size_t WS_DELTA = 480 * MiB;
constexpr size_t WS_WIN = 16 * MiB;
constexpr size_t WS_WPA = 58 * MiB, WS_WPB = 62 * MiB, WS_WOUT = 66 * MiB;
constexpr size_t WS_WLORA = 74 * MiB;
constexpr size_t WS_WRT = 76 * MiB;
constexpr size_t WS_H = 80 * MiB;
constexpr size_t WS_Q = 144 * MiB, WS_K = 176 * MiB, WS_V = 208 * MiB, WS_G = 240 * MiB, WS_RW = 368 * MiB;
constexpr size_t WS_RS = 480 * MiB, WS_KS = 512 * MiB, WS_VS = 544 * MiB, WS_LA = 576 * MiB, WS_LD = 600 * MiB, WS_AS = 664 * MiB, WS_GG = 696 * MiB, WS_Y = 728 * MiB;
constexpr size_t WS_O = 368 * MiB;
constexpr size_t WS_YA = 144 * MiB, WS_YB = 176 * MiB;
constexpr size_t WS_TMP = 480 * MiB;
constexpr size_t WS_MERGED = 600 * MiB;
constexpr size_t WS_H8 = 792 * MiB, WS_WIN8 = 824 * MiB;
constexpr size_t WS_WGU = 792 * MiB, WS_WD = 920 * MiB;
constexpr size_t WS_LOGIT = 432 * MiB;
constexpr size_t WS_XG = 144 * MiB, WS_ACT = 224 * MiB, WS_YD = 272 * MiB, WS_END = 984 * MiB;
constexpr int CW_CNT = 64;
constexpr int CW_BAR = 4096;
constexpr int RING_OFF = 0, RING_BYTES = 131072;
constexpr int LDSCTL_OFF = RING_BYTES, MISC_OFF = LDSCTL_OFF + 320;
constexpr int TT_OFF = LDSCTL_OFF + 1024;
constexpr int LDS_BYTES = 147456;

typedef unsigned short bfu;
typedef unsigned u32x2 __attribute__((ext_vector_type(2)));
typedef float f32x2 __attribute__((ext_vector_type(2)));

__device__ __forceinline__ float wave_sum(float v) {
#pragma unroll
    for (int o = 1; o < 64; o <<= 1) v += __shfl_xor(v, o);
    return v;
}
__device__ __forceinline__ float bfl(unsigned w) { return __uint_as_float(w << 16); }
__device__ __forceinline__ float bfh(unsigned w) { return __uint_as_float(w & 0xffff0000u); }
__device__ __forceinline__ float sigm(float x) { return 1.0f / (1.0f + __expf(-x)); }
__device__ __forceinline__ void unpack16(const v4u a, const v4u b, float (&x)[16]) {
    x[0] = bfl(a.x); x[1] = bfh(a.x); x[2] = bfl(a.y); x[3] = bfh(a.y); x[4] = bfl(a.z); x[5] = bfh(a.z); x[6] = bfl(a.w); x[7] = bfh(a.w);
    x[8] = bfl(b.x); x[9] = bfh(b.x); x[10] = bfl(b.y); x[11] = bfh(b.y); x[12] = bfl(b.z); x[13] = bfh(b.z); x[14] = bfl(b.w); x[15] = bfh(b.w);
}
__device__ __forceinline__ void pack16(const float (&x)[16], v4u& a, v4u& b) {
    a.x = pk2(x[0], x[1]); a.y = pk2(x[2], x[3]); a.z = pk2(x[4], x[5]); a.w = pk2(x[6], x[7]);
    b.x = pk2(x[8], x[9]); b.y = pk2(x[10], x[11]); b.z = pk2(x[12], x[13]); b.w = pk2(x[14], x[15]);
}
__device__ __forceinline__ float dpp_f(float v, int ctrl_sel) {
    const int x = __builtin_bit_cast(int, v); int r;
    if (ctrl_sel == 0) r = __builtin_amdgcn_update_dpp(0, x, 0xB1, 0xF, 0xF, true);
    else if (ctrl_sel == 1) r = __builtin_amdgcn_update_dpp(0, x, 0x4E, 0xF, 0xF, true);
    else if (ctrl_sel == 2) r = __builtin_amdgcn_update_dpp(0, x, 0x141, 0xF, 0xF, true);
    else r = __builtin_amdgcn_update_dpp(0, x, 0x140, 0xF, 0xF, true);
    return __builtin_bit_cast(float, r);
}
__device__ __forceinline__ float row16_sum(float v) { v += dpp_f(v, 0); v += dpp_f(v, 1); v += dpp_f(v, 2); v += dpp_f(v, 3); return v; }
__device__ __forceinline__ float oct_sum(float v) { v += dpp_f(v, 0); v += dpp_f(v, 1); v += dpp_f(v, 2); return v; }
__device__ __forceinline__ float quad_sum(float v) { v += dpp_f(v, 0); v += dpp_f(v, 1); return v; }

__device__ __forceinline__ void transpose_item(const float* W, int ldw, int k0, int n0, bfu* WT, int ldk, size_t drow0, LAS float* scr, int lane) {
#pragma unroll 8
    for (int i = 0; i < 32; ++i) { const int kk = 2 * i + (lane >> 5); scr[kk * 33 + (lane & 31)] = W[(size_t)(k0 + kk) * ldw + n0 + (lane & 31)]; }
    LDS_WAIT(); asm volatile("" ::: "memory");
    const int c = lane & 7;
#pragma unroll
    for (int j = 0; j < 4; ++j) { const int n = (lane >> 3) + 8 * j; const LAS float* s = scr + (8 * c) * 33 + n;
        v4u o; o.x = pk2(s[0 * 33], s[1 * 33]); o.y = pk2(s[2 * 33], s[3 * 33]); o.z = pk2(s[4 * 33], s[5 * 33]); o.w = pk2(s[6 * 33], s[7 * 33]);
        *(GAS v4u*)(WT + (drow0 + n) * ldk + k0 + 8 * c) = o; }
    LDS_WAIT(); asm volatile("" ::: "memory");
}

__device__ __forceinline__ unsigned pk4f8(float a, float b, float c, float d) { int w = 0; w = __builtin_amdgcn_cvt_pk_fp8_f32(a, b, w, false); w = __builtin_amdgcn_cvt_pk_fp8_f32(c, d, w, true); return (unsigned)w; }
__device__ __forceinline__ unsigned pk4f8c(float a, float b, float c, float d) { return pk4f8(__builtin_amdgcn_fmed3f(a, -448.f, 448.f), __builtin_amdgcn_fmed3f(b, -448.f, 448.f), __builtin_amdgcn_fmed3f(c, -448.f, 448.f), __builtin_amdgcn_fmed3f(d, -448.f, 448.f)); }
__device__ __forceinline__ void transpose_item8(const float* W, int ldw, int k0, int n0, unsigned char* WT, int ldk, size_t drow0, float sc, LAS float* scr, int lane) {
#pragma unroll 8
    for (int i = 0; i < 32; ++i) { const int kk = 2 * i + (lane >> 5); scr[kk * 33 + (lane & 31)] = W[(size_t)(k0 + kk) * ldw + n0 + (lane & 31)]; }
    LDS_WAIT(); asm volatile("" ::: "memory");
    const int c = lane & 3;
#pragma unroll
    for (int j = 0; j < 2; ++j) { const int n = (lane >> 2) + 16 * j; const LAS float* s = scr + (16 * c) * 33 + n;
        v4u o; o.x = pk4f8(s[0 * 33] * sc, s[1 * 33] * sc, s[2 * 33] * sc, s[3 * 33] * sc); o.y = pk4f8(s[4 * 33] * sc, s[5 * 33] * sc, s[6 * 33] * sc, s[7 * 33] * sc);
        o.z = pk4f8(s[8 * 33] * sc, s[9 * 33] * sc, s[10 * 33] * sc, s[11 * 33] * sc); o.w = pk4f8(s[12 * 33] * sc, s[13 * 33] * sc, s[14 * 33] * sc, s[15 * 33] * sc);
        *(GAS v4u*)(WT + (drow0 + n) * ldk + k0 + 16 * c) = o; }
    LDS_WAIT(); asm volatile("" ::: "memory");
}
constexpr float SA_H = 16.f, SB_W = 256.f, SA_ACT = 8.f, SA_M = 32.f, SA_Y = 16.f;
template <bool F8> __device__ __forceinline__ void rms_row_to_bf16(const float* xrow, const float* g, bfu* orow, unsigned char* o8row, int lane, float eps) {
    const GAS f32x4* xr = (const GAS f32x4*)xrow + lane; const GAS f32x4* gr = (const GAS f32x4*)g + lane;
    f32x4 v[8]; float s = 0.f;
#pragma unroll
    for (int j = 0; j < 8; ++j) { v[j] = xr[64 * j]; s += (v[j].x * v[j].x + v[j].y * v[j].y) + (v[j].z * v[j].z + v[j].w * v[j].w); }
    const float rstd = 1.0f / sqrtf(wave_sum(s) * (1.f / 2048.f) + eps);
    GAS unsigned long long* o8 = (GAS unsigned long long*)orow + lane;
#pragma unroll
    for (int j = 0; j < 8; ++j) { const f32x4 gg = gr[64 * j]; const float a0 = v[j].x * rstd * gg.x, a1 = v[j].y * rstd * gg.y, a2 = v[j].z * rstd * gg.z, a3 = v[j].w * rstd * gg.w;
        o8[64 * j] = (unsigned long long)pk2(a0, a1) | ((unsigned long long)pk2(a2, a3) << 32);
        if (F8) ((GAS unsigned*)o8row)[lane + 64 * j] = pk4f8c(a0 * SA_H, a1 * SA_H, a2 * SA_H, a3 * SA_H); }
}
typedef const __attribute__((address_space(4))) unsigned char* kaptr_t;
#define PH_BEGIN() kaptr_t ka_ = (kaptr_t)__builtin_amdgcn_kernarg_segment_ptr(); asm volatile("" : "+s"(ka_)); unsigned char* const ws = *(unsigned char* const __attribute__((address_space(4)))*)(ka_ + 264); (void)ws; int lane = (int)threadIdx.x; asm volatile("" : "+v"(lane)); lane &= 63
#define INP(k) (*(const float* const __attribute__((address_space(4)))*)(ka_ + 8 * (k)))
#define OUTP (*(float* const __attribute__((address_space(4)))*)(ka_ + 256))
#define ctl ((gu32*)(ws + WS_CTL))
#define Hb ((bfu*)(ws + WS_H))
#define Qb ((bfu*)(ws + WS_Q))
#define Kb ((bfu*)(ws + WS_K))
#define Vb ((bfu*)(ws + WS_V))
#define Gb ((bfu*)(ws + WS_G))
#define RWb ((bfu*)(ws + WS_RW))
#define RSb ((bfu*)(ws + WS_RS))
#define KSb ((bfu*)(ws + WS_KS))
#define VSb ((bfu*)(ws + WS_VS))
#define LAb ((bfu*)(ws + WS_LA))
#define LDf ((float*)(ws + WS_LD))
#define ASb ((bfu*)(ws + WS_AS))
#define GGb ((bfu*)(ws + WS_GG))
#define Yf ((float*)(ws + WS_Y))
#define Ob ((bfu*)(ws + WS_O))
#define YAb ((bfu*)(ws + WS_YA))
#define YBb ((bfu*)(ws + WS_YB))
#define TMPb ((bfu*)(ws + WS_TMP))
#define MRGb ((bfu*)(ws + WS_MERGED))
#define WINt ((bfu*)(ws + WS_WIN))
#define WPAt ((bfu*)(ws + WS_WPA))
#define WPBt ((bfu*)(ws + WS_WPB))
#define WOUTt ((bfu*)(ws + WS_WOUT))
#define WLORAt ((bfu*)(ws + WS_WLORA))
#define WRTt ((bfu*)(ws + WS_WRT))
#define H8p ((unsigned char*)(ws + WS_H8))
#define WIN8p ((unsigned char*)(ws + WS_WIN8))
#define WGUt ((bfu*)(ws + WS_WGU))
#define WDt ((bfu*)(ws + WS_WD))
#define ROPE ((float*)(ws + WS_ROPE))
#define BON ((float*)(ws + WS_BON))
#define ASG_E ((int*)(ws + WS_ASG_E))
#define ASG_POS ((int*)(ws + WS_ASG_POS))
#define ASG_GATE ((float*)(ws + WS_ASG_GATE))
#define TOKDEST ((int*)(ws + WS_TOKDEST))
#define ROWGATE ((float*)(ws + WS_ROWGATE))
#define CNTT ((int*)(ws + WS_CNTT))
#define RSTD ((float*)(ws + WS_RSTD))
#define DELTAb ((bfu*)(ws + WS_DELTA))
#define LOGIT ((float*)(ws + WS_LOGIT))
#define XGb ((bfu*)(ws + WS_XG))
#define ACTb ((bfu*)(ws + WS_ACT))
#define YDb ((bfu*)(ws + WS_YD))
static_assert(sizeof(void*) == 8, "kernarg offsets");

#ifndef DBG_BONV
#define DBG_BONV bs
#endif
struct Args { const float* in[32]; float* out; unsigned char* ws; int ph_lo, ph_hi, li, pad; };

__global__ void __launch_bounds__(NWAVES * 64, 2) mk_fwd(Args args) {
    extern __shared__ __attribute__((aligned(16))) unsigned char lds[];
    LAS unsigned char* L = (LAS unsigned char*)lds;
    volatile LAS unsigned* MISC = (volatile LAS unsigned*)(L + MISC_OFF);
    const int tid = threadIdx.x, wave = __builtin_amdgcn_readfirstlane(tid >> 6);
    const int G = gridDim.x; const int bx = blockIdx.x; const int vcu = (G % 8 == 0) ? (bx % 8) * (G / 8) + bx / 8 : bx;
    const int gw = vcu * NWAVES + wave, NGW = G * NWAVES;
    for (int u = tid; u < (LDS_BYTES - LDSCTL_OFF) / 4; u += NWAVES * 64) ((LAS unsigned*)(L + LDSCTL_OFF))[u] = 0u;
    __syncthreads();
    XcdBarrier bar; { unsigned char* const ws = args.ws; unsigned* const bw = (unsigned*)(ctl + CW_BAR) + args.li * XCD_BAR_WORDS; bar.bar = bw; bar.x = 0; bar.st = nullptr;
    if (!MK_SPLIT) bar = xcd_barrier_post(bw, MISC + 8); }
    const int lo = args.ph_lo, hi = args.ph_hi;
#ifdef PH_ONLY
#define IN(k) ((k) == PH_ONLY && lo <= (k) && (k) < hi)
#else
#define IN(k) (lo <= (k) && (k) < hi)
#endif
#define SEAM() do { if (!MK_SPLIT) xcd_barrier(bar); } while (0)

    if (IN(0)) { PH_BEGIN();
        LAS float* scr = (LAS float*)(L + RING_OFF + wave * 16384);
        {
            const float* W = INP(2); constexpr int NB = NIN_SRC / 32, NIT = 32 * NB;
            for (int it = gw; it < NIT; it += NGW) { const int kb = it / NB, nb = it % NB, n0 = 32 * nb; const int drow = n0 + (n0 >= 6592 ? 64 : 0), tile = drow >> 8;
                if ((tile >= 8 && tile < 12) || tile >= 26) transpose_item8(W, NIN_SRC, 64 * kb, n0, WIN8p, 2048, (size_t)drow, SB_W, scr, lane);
                else transpose_item(W, NIN_SRC, 64 * kb, n0, WINt, 2048, (size_t)drow, scr, lane); }
            for (int i = gw * 64 + lane; i < 64 * 2048 / 8; i += NGW * 64) *(GAS v4u*)(WINt + (size_t)6592 * 2048 + (size_t)i * 8) = (v4u){0u, 0u, 0u, 0u};
        }
        { const float* W = INP(21); for (int it = gw; it < 16 * 64; it += NGW) { const int kb = it / 64, nb = it % 64;
            if (PROJ_F8) transpose_item8(W, 2048, 64 * kb, 32 * nb, (unsigned char*)WPAt, 1024, (size_t)(32 * nb), SB_W, scr, lane); else transpose_item(W, 2048, 64 * kb, 32 * nb, WPAt, 1024, (size_t)(32 * nb), scr, lane); } }
        { const float* W = INP(22); for (int it = gw; it < 16 * 64; it += NGW) { const int kb = it / 64, nb = it % 64;
            if (PROJ_F8) transpose_item8(W, 2048, 64 * kb, 32 * nb, (unsigned char*)WPBt, 1024, (size_t)(32 * nb), SB_W, scr, lane); else transpose_item(W, 2048, 64 * kb, 32 * nb, WPBt, 1024, (size_t)(32 * nb), scr, lane); } }
        { const float* W = INP(23); for (int it = gw; it < 32 * 64; it += NGW) { const int kb = it / 64, nb = it % 64;
            if (WOUT_F8) transpose_item8(W, 2048, 64 * kb, 32 * nb, (unsigned char*)WOUTt, 2048, (size_t)(32 * nb), SB_W, scr, lane); else transpose_item(W, 2048, 64 * kb, 32 * nb, WOUTt, 2048, (size_t)(32 * nb), scr, lane); } }
        {
            const float* wu = INP(12); const float* au = INP(14); const float* gu = INP(15);
            for (int it = gw * 64 + lane; it < 3 * 32 * 1024; it += NGW * 64) { const int n = it & 1023, kg = (it >> 10) & 31, which = it >> 15; const float* src = which == 0 ? wu : (which == 1 ? au : gu); const int kmax = which == 2 ? 256 : 96;
                float v[8];
#pragma unroll
                for (int j = 0; j < 8; ++j) { const int k = kg * 8 + j; v[j] = k < kmax ? src[(size_t)k * 1024 + n] : 0.f; }
                v4u o; o.x = pk2(v[0], v[1]); o.y = pk2(v[2], v[3]); o.z = pk2(v[4], v[5]); o.w = pk2(v[6], v[7]);
                *(GAS v4u*)(WLORAt + ((size_t)(which * 1024 + n) * 256 + kg * 8)) = o; }
        }
        {
            const float* rg = INP(25); const float* re = INP(27); const float* g2w = INP(24);
            for (int it = gw * 64 + lane; it < 256 * 256; it += NGW * 64) { const int n = it & 255, kg = it >> 8; float v[8];
#pragma unroll
                for (int j = 0; j < 8; ++j) { const int k = kg * 8 + j; v[j] = (n < 4 ? rg[k * 4 + n] : (n < 36 ? re[k * 32 + (n - 4)] : 0.f)) * g2w[k]; }
                v4u o; o.x = pk2(v[0], v[1]); o.y = pk2(v[2], v[3]); o.z = pk2(v[4], v[5]); o.w = pk2(v[6], v[7]);
                *(GAS v4u*)(WRTt + ((size_t)n * 2048 + kg * 8)) = o; }
        }
#ifdef DBG_ZERO_AS
        for (size_t i = (size_t)gw * 64 + lane; i < (size_t)T_ * 1024 / 8; i += (size_t)NGW * 64) *(GAS v4u*)(ASb + i * 8) = (v4u){0u, 0u, 0u, 0u};
#endif
        for (int it = gw * 64 + lane; it < 4096 * 8; it += NGW * 64) { const int pos = it >> 3, i = it & 7; const float inv = exp2f(-(float)i * 0.125f * 18.931568569324174f);
            const float ang = (float)pos * inv; const float n = rintf(ang * 0.15915494309189535f); float r = fmaf(-n, 6.28125f, ang); r = fmaf(-n, 0.0019353071795864769f, r);
            ROPE[it] = __cosf(r); ROPE[4096 * 8 + it] = __sinf(r); }
        for (int m = gw; m < T_; m += NGW) rms_row_to_bf16<true>(INP(0) + (size_t)m * 2048, INP(1), Hb + (size_t)m * 2048, H8p + (size_t)m * 2048, lane, 1e-6f);
        SEAM();
    }

    if (IN(1)) { PH_BEGIN();
        const bool f8first = (G == 256 && (bx & 7) >= 4);
        if (f8first) { pg8::Gemm g{(const bfu*)H8p, (const bfu*)WIN8p, 1024, 1024}; pg8::WinOrder S; S.so.init(T_, 20 * 256, G, bx); S.f8 = 1;
          pg8::EpiWin E{Qb, Kb, Vb, RWb, Gb, 1.0f / (SA_H * SB_W)};
          pg8::gemm_phase8<pg8::EpiWin, pg8::WinOrder, true, true>(L + RING_OFF, g, S, E); }
        { pg8::Gemm g{Hb, WINt, 2048, 2048}; pg8::WinOrder S; S.so.init(T_, 22 * 256, G, bx); S.f8 = 0;
          pg8::EpiWin E{Qb, Kb, Vb, RWb, Gb, 1.0f};
          pg8::gemm_phase<pg8::EpiWin, pg8::WinOrder, true, true>(L + RING_OFF, g, S, E); }
        if (!f8first) { pg8::Gemm g{(const bfu*)H8p, (const bfu*)WIN8p, 1024, 1024}; pg8::WinOrder S; S.so.init(T_, 20 * 256, G, bx); S.f8 = 1;
          pg8::EpiWin E{Qb, Kb, Vb, RWb, Gb, 1.0f / (SA_H * SB_W)};
          pg8::gemm_phase8<pg8::EpiWin, pg8::WinOrder, true, true>(L + RING_OFF, g, S, E); }
        SEAM();
    }

    if (IN(2)) { PH_BEGIN();
        const float* qg = INP(3); const float* kg = INP(4); const float* mu = INP(10);
        const int quarter = lane & 3;
        float gq[16], gk[16], mur[16], muk[16], muv[16], mul[7];
#pragma unroll
        for (int i = 0; i < 16; ++i) { gq[i] = qg[16 * quarter + i]; gk[i] = kg[16 * quarter + i]; mur[i] = mu[16 * lane + i]; muk[i] = mu[1024 + 16 * lane + i]; muv[i] = mu[2048 + 16 * lane + i]; }
#pragma unroll
        for (int i = 0; i < 7; ++i) mul[i] = mu[3072 + lane + 64 * i];
        const float QSC = 0.125f * 1.4426950408889634f;
        for (int m = gw; m < T_; m += NGW) {
            const int pos = m & (SEQL - 1);
            float cs[8], sn[8];
            if (quarter == 0) {
#pragma unroll
                for (int i = 0; i < 8; ++i) { cs[i] = ROPE[pos * 8 + i]; sn[i] = ROPE[4096 * 8 + pos * 8 + i]; }
            }
#pragma unroll
            for (int qk = 0; qk < 2; ++qk) {
                bfu* p = (qk == 0 ? Qb : Kb) + (size_t)m * 1024 + 16 * lane;
                const v4u a = *(const GAS v4u*)p, b = *(const GAS v4u*)(p + 8);
                float xv[16]; unpack16(a, b, xv);
                float ss = 0.f;
#pragma unroll
                for (int i = 0; i < 16; ++i) ss += xv[i] * xv[i];
                ss = quad_sum(ss);
                const float rstd = 1.0f / sqrtf(ss * (1.f / 64.f) + 1e-6f);
#pragma unroll
                for (int i = 0; i < 16; ++i) xv[i] = xv[i] * rstd * (qk == 0 ? gq[i] : gk[i]);
                if (quarter == 0) {
#pragma unroll
                    for (int i = 0; i < 8; ++i) { const float x1 = xv[i], x2 = xv[8 + i]; xv[i] = x1 * cs[i] - x2 * sn[i]; xv[8 + i] = x2 * cs[i] + x1 * sn[i]; }
                }
                if (qk == 0) {
#pragma unroll
                    for (int i = 0; i < 16; ++i) xv[i] *= QSC;
                }
                v4u oa, ob; pack16(xv, oa, ob);
                *(GAS v4u*)p = oa; *(GAS v4u*)(p + 8) = ob;
            }
            const bool has_prev = pos != 0;
            const bfu* cur = RWb + (size_t)m * RWW; const bfu* prv = cur - RWW;
#pragma unroll
            for (int seg = 0; seg < 3; ++seg) {
                const bfu* pc = cur + seg * 1024 + 16 * lane; const bfu* pp = prv + seg * 1024 + 16 * lane;
                const v4u a = *(const GAS v4u*)pc, b = *(const GAS v4u*)(pc + 8);
                v4u c = (v4u){0u, 0u, 0u, 0u}, d = c;
                if (has_prev) { c = *(const GAS v4u*)pp; d = *(const GAS v4u*)(pp + 8); }
                float xc[16], xp[16]; unpack16(a, b, xc); unpack16(c, d, xp);
#pragma unroll
                for (int i = 0; i < 16; ++i) { const float mm = seg == 0 ? mur[i] : (seg == 1 ? muk[i] : muv[i]); xc[i] = xc[i] + (xp[i] - xc[i]) * mm; }
                v4u oa, ob; pack16(xc, oa, ob);
                bfu* po = (seg == 0 ? RSb : (seg == 1 ? KSb : VSb)) + (size_t)m * 1024 + 16 * lane;
                *(GAS v4u*)po = oa; *(GAS v4u*)(po + 8) = ob;
            }
            bfu* law = LAb + (size_t)m * 256; bfu* laa = LAb + (size_t)(T_ + m) * 256; bfu* lag = LAb + (size_t)(2 * T_ + m) * 256;
#pragma unroll
            for (int i = 0; i < 7; ++i) {
                const int c = lane + 64 * i;
                const float xc = bfl((unsigned)cur[3072 + c]); const float xp = has_prev ? bfl((unsigned)prv[3072 + c]) : 0.f;
                const float z = xc + (xp - xc) * mul[i];
                if (c < 96) { const float e2 = __expf(2.f * z); law[c] = (bfu)f2bf(1.0f - 2.0f / (e2 + 1.0f)); }
                else if (c < 192) laa[c - 96] = (bfu)f2bf(z);
                else lag[c - 192] = (bfu)f2bf(sigm(z));
            }
            for (int c = 96 + lane; c < 256; c += 64) { law[c] = 0; laa[c] = 0; }
        }
        SEAM();
    }

    if (IN(3)) { PH_BEGIN();
        const attn_body::AttnTensors AT{(const attn_body::bf16*)Qb, (const attn_body::bf16*)Kb, (const attn_body::bf16*)Vb, (attn_body::bf16*)Ob};
        attn_body::attn_phase<8>((char*)lds + RING_OFF, AT, vcu, G);
    }

    if (IN(4)) { PH_BEGIN();
        pg8::Gemm g{LAb, WLORAt, 256, 256}; pg8::LoraOrder S; S.so.init(3 * T_, 1024, G, bx);
        pg8::EpiLora E{LDf, ASb, GGb, INP(11), INP(13)};
        pg8::gemm_phase<pg8::EpiLora, pg8::LoraOrder, true, true>(L + RING_OFF, g, S, E);
        SEAM();
    }
    if (IN(5)) { PH_BEGIN();
        constexpr int TC = 32, NCH = SEQL / TC;
        constexpr int OPF = TC * 320, SCF = TC * 32, BUF_F = OPF + SCF;
        LAS float* SB = (LAS float*)(L + RING_OFF);
        LAS float* YS = SB + 2 * BUF_F;
        LAS float* YDM = YS + 2 * TC * 16;
        static_assert((2 * BUF_F + 2 * TC * 16) * 4 + 2304 <= 96768 && 96768 + 4 * 8448 <= RING_BYTES, "scan LDS map");
#define SCAN_BAR() do { asm volatile("s_waitcnt lgkmcnt(0)" ::: "memory"); __builtin_amdgcn_s_barrier(); asm volatile("" ::: "memory"); } while (0)
        int n_conv = 0;
        const int conv_first = vcu * 4 + (wave - 4), conv_stride = G * 4;
        const int conv_last = conv_first + ((3 * 32 * 1024 - 1 - conv_first) / conv_stride) * conv_stride;
#ifdef EXP_CONV_AFTER
        constexpr int N_CONV_IN = 0;
#else
        constexpr int N_CONV_IN = 3 * 32 * 1024;
#endif
        constexpr int N_CONV = 3 * 32 * 1024;
        const float* wg_ = INP(29); const float* wu_ = INP(30); const float* wd_ = INP(31);
        unsigned char* const WGU8 = (unsigned char*)WGUt; unsigned char* const WD8 = (unsigned char*)WDt;
        f32x4 cva[8], cvb[8];
#pragma unroll
        for (int i = 0; i < 8; ++i) { cva[i] = (f32x4){0.f, 0.f, 0.f, 0.f}; cvb[i] = (f32x4){0.f, 0.f, 0.f, 0.f}; }
        LAS float* cscr = (LAS float*)(L + ((wave & 3) < 3 ? 96768 + (wave & 3) * 8704 : 135168));
#define CONV_SRC(gi, W_, ldw_, k0_, n0_, WT_, ldk_, drow_) const float* W_; int ldw_, k0_, n0_, ldk_; size_t drow_; unsigned char* WT_; \
        if ((gi) < 65536) { const int up_ = (gi) >> 15, r_ = (gi) & 32767, e_ = r_ >> 10, kb_ = (r_ >> 5) & 31, nb_ = r_ & 31; n0_ = 32 * nb_; k0_ = 64 * kb_; W_ = (up_ ? wu_ : wg_) + (size_t)e_ * 2048 * 1024; ldw_ = 1024; \
            WT_ = WGU8; ldk_ = 2048; drow_ = (size_t)e_ * 2048 + (n0_ >> 7) * 256 + (n0_ & 127) + up_ * 128; } \
        else { const int it_ = (gi) - 65536, e_ = it_ >> 10, kb_ = (it_ >> 6) & 15, nb_ = it_ & 63; n0_ = 32 * nb_; k0_ = 64 * kb_; W_ = wd_ + (size_t)e_ * 1024 * 2048; ldw_ = 2048; WT_ = WD8; ldk_ = 1024; drow_ = (size_t)e_ * 2048 + n0_; }
#define CONV_ISSUE(gi, cv) do { CONV_SRC(gi, W_, ldw_, k0_, n0_, WT_, ldk_, drow_); (void)WT_; (void)ldk_; (void)drow_; int l_ = lane; asm volatile("" : "+v"(l_)); \
        const float* p_ = W_ + (size_t)(k0_ + (l_ >> 3)) * ldw_ + n0_ + 4 * (l_ & 7); \
        _Pragma("unroll") for (int i = 0; i < 8; ++i) cv[i] = *(const GAS f32x4*)(p_ + (size_t)(8 * i) * ldw_); } while (0)
#define CONV_FINISH(gi, cv) do { CONV_SRC(gi, W_, ldw_, k0_, n0_, WT_, ldk_, drow_); (void)W_; (void)ldw_; \
        { LAS float* w_ = cscr + (lane & 7) * 68 + (lane >> 3);                     \
          _Pragma("unroll") for (int i = 0; i < 8; ++i) { w_[8 * i] = cv[i].x; w_[8 * 68 + 8 * i] = cv[i].y; w_[16 * 68 + 8 * i] = cv[i].z; w_[24 * 68 + 8 * i] = cv[i].w; } } \
        LDS_WAIT(); asm volatile("" ::: "memory"); \
        { const int c4 = (lane >> 3) & 3; _Pragma("unroll") for (int j = 0; j < 2; ++j) { const int nl_ = (lane & 7) + 8 * ((lane >> 5) & 1) + 16 * j, n = 4 * (nl_ & 7) + (nl_ >> 3); \
            const LAS f32x4* s4_ = (const LAS f32x4*)(cscr + nl_ * 68 + 16 * c4);     \
            const f32x4 a_ = s4_[0] * SB_W, b_ = s4_[1] * SB_W, c_ = s4_[2] * SB_W, d_ = s4_[3] * SB_W; \
            v4u o; o.x = pk4f8(a_.x, a_.y, a_.z, a_.w); o.y = pk4f8(b_.x, b_.y, b_.z, b_.w); o.z = pk4f8(c_.x, c_.y, c_.z, c_.w); o.w = pk4f8(d_.x, d_.y, d_.z, d_.w); \
            *(GAS v4u*)(WT_ + (drow_ + n) * ldk_ + k0_ + 16 * c4) = o; } } \
        LDS_WAIT(); asm volatile("" ::: "memory"); } while (0)
        const float* k_k = INP(16); const float* k_a = INP(17); const float* r_k = INP(18);
        for (int unit = vcu; unit < 256; unit += G) {
            const int bh = unit >> 2, rq = unit & 3, b = bh >> 4, h = bh & 15;
            const size_t row0 = (size_t)b * SEQL;
            if (wave >= 4) {
                const int t2 = tid - 256, tk = t2 >> 3, part = t2 & 7, col = h * 64 + 8 * part;
                float kkc[8], kac[8], rkc[8];
#pragma unroll
                for (int i = 0; i < 8; ++i) { kkc[i] = k_k[col + i]; kac[i] = k_a[col + i]; rkc[i] = r_k[col + i]; }
                v4u rk8a, ra8a, rr8a, rv8a, rk8b, ra8b, rr8b, rv8b; f32x4 rl0a, rl1a, rl0b, rl1b;
#define SCAN_LOAD(c, X) do { const int cl_ = (c) < NCH ? (c) : NCH - 1; const size_t mrow = row0 + (size_t)cl_ * TC + tk; rk8##X = *(const GAS v4u*)(KSb + mrow * 1024 + col); ra8##X = *(const GAS v4u*)(ASb + mrow * 1024 + col); rr8##X = *(const GAS v4u*)(RSb + mrow * 1024 + col); \
        rl0##X = *(const GAS f32x4*)(LDf + mrow * 1024 + col); rl1##X = *(const GAS f32x4*)(LDf + mrow * 1024 + col + 4); rv8##X = *(const GAS v4u*)(VSb + mrow * 1024 + h * 64 + 16 * rq + 8 * (part & 1)); } while (0)
#define SCAN_STAGE(c, X) do { LAS float* B_ = SB + ((c) & 1) * BUF_F; float kv[8], av[8], rv[8], lv[8]; const v4u rk8 = rk8##X, ra8 = ra8##X, rr8 = rr8##X, rv8 = rv8##X; const f32x4 rl0 = rl0##X, rl1 = rl1##X; \
        kv[0] = bfl(rk8.x); kv[1] = bfh(rk8.x); kv[2] = bfl(rk8.y); kv[3] = bfh(rk8.y); kv[4] = bfl(rk8.z); kv[5] = bfh(rk8.z); kv[6] = bfl(rk8.w); kv[7] = bfh(rk8.w); \
        av[0] = bfl(ra8.x); av[1] = bfh(ra8.x); av[2] = bfl(ra8.y); av[3] = bfh(ra8.y); av[4] = bfl(ra8.z); av[5] = bfh(ra8.z); av[6] = bfl(ra8.w); av[7] = bfh(ra8.w); \
        rv[0] = bfl(rr8.x); rv[1] = bfh(rr8.x); rv[2] = bfl(rr8.y); rv[3] = bfh(rr8.y); rv[4] = bfl(rr8.z); rv[5] = bfh(rr8.z); rv[6] = bfl(rr8.w); rv[7] = bfh(rr8.w); \
        lv[0] = rl0.x; lv[1] = rl0.y; lv[2] = rl0.z; lv[3] = rl0.w; lv[4] = rl1.x; lv[5] = rl1.y; lv[6] = rl1.z; lv[7] = rl1.w; \
        float kkv[8], ss = 0.f, bs = 0.f, brs = 0.f, krs = 0.f; \
        _Pragma("unroll") for (int i = 0; i < 8; ++i) { kkv[i] = kv[i] * kkc[i]; ss += kkv[i] * kkv[i]; } \
        ss = oct_sum(ss); const float inv = 1.0f / fmaxf(sqrtf(ss), 1e-12f); \
        float ow[8], ok[8], ob[8], oa[8], oq[8]; \
        _Pragma("unroll") for (int i = 0; i < 8; ++i) { const float kk = kkv[i] * inv; ok[i] = kv[i] * (1.0f + (av[i] - 1.0f) * kac[i]); oa[i] = -kk; ob[i] = kk * av[i]; ow[i] = __expf(lv[i]); oq[i] = ow[i] * rv[i]; \
            bs += rv[i] * ok[i] * rkc[i]; brs += ob[i] * rv[i]; krs += ok[i] * rv[i]; } \
        bs = oct_sum(bs); brs = oct_sum(brs); krs = oct_sum(krs); \
        _Pragma("unroll") for (int i = 0; i < 8; ++i) oq[i] += brs * oa[i]; \
        if (rq == 0 && part == 0) BON[(row0 + (size_t)(c) * TC + tk) * 16 + h] = bs; \
        LAS float* d_ = B_ + tk * 320 + part * 40; \
        *(LAS f32x4*)(d_) = (f32x4){ow[0], ow[1], ow[2], ow[3]}; *(LAS f32x4*)(d_ + 4) = (f32x4){ok[0], ok[1], ok[2], ok[3]}; *(LAS f32x4*)(d_ + 8) = (f32x4){ob[0], ob[1], ob[2], ob[3]}; \
        *(LAS f32x4*)(d_ + 12) = (f32x4){oa[0], oa[1], oa[2], oa[3]}; *(LAS f32x4*)(d_ + 16) = (f32x4){oq[0], oq[1], oq[2], oq[3]}; \
        *(LAS f32x4*)(d_ + 20) = (f32x4){ow[4], ow[5], ow[6], ow[7]}; *(LAS f32x4*)(d_ + 24) = (f32x4){ok[4], ok[5], ok[6], ok[7]}; *(LAS f32x4*)(d_ + 28) = (f32x4){ob[4], ob[5], ob[6], ob[7]}; \
        *(LAS f32x4*)(d_ + 32) = (f32x4){oa[4], oa[5], oa[6], oa[7]}; *(LAS f32x4*)(d_ + 36) = (f32x4){oq[4], oq[5], oq[6], oq[7]}; \
        LAS float* ds_ = B_ + OPF + tk * 32 + 16 * part; \
        if (part < 2) { const float v0_ = bfl(rv8.x), v1_ = bfh(rv8.x), v2_ = bfl(rv8.y), v3_ = bfh(rv8.y), v4_ = bfl(rv8.z), v5_ = bfh(rv8.z), v6_ = bfl(rv8.w), v7_ = bfh(rv8.w); \
            *(LAS f32x4*)(ds_) = (f32x4){v0_, v0_ * krs, v1_, v1_ * krs}; *(LAS f32x4*)(ds_ + 4) = (f32x4){v2_, v2_ * krs, v3_, v3_ * krs}; \
            *(LAS f32x4*)(ds_ + 8) = (f32x4){v4_, v4_ * krs, v5_, v5_ * krs}; *(LAS f32x4*)(ds_ + 12) = (f32x4){v6_, v6_ * krs, v7_, v7_ * krs}; } } while (0)
#define SCAN_YOUT(c) do { const LAS float* ys = YS + ((c) & 1) * (TC * 16) + tk * 16 + 2 * part; const float y0 = ys[0], y1 = ys[1]; \
        float* yo = Yf + (row0 + (size_t)(c) * TC + tk) * 1024 + h * 64 + 16 * rq + 2 * part; *(GAS f32x2*)yo = (f32x2){y0, y1}; } while (0)
                SCAN_LOAD(0, a); SCAN_STAGE(0, a); SCAN_LOAD(1, b); SCAN_LOAD(2, a);
                { const int g0 = conv_first + n_conv * conv_stride, g1 = g0 + conv_stride; const int c0_ = g0 < conv_last ? g0 : conv_last, c1_ = g1 < conv_last ? g1 : conv_last; CONV_ISSUE(c0_, cva); CONV_ISSUE(c1_, cvb); }
                SCAN_BAR();
                static_assert(NCH % 2 == 0, "the chunk loop runs two chunks per trip (item parity = chunk parity)");
                for (int c2 = 0; c2 < NCH; c2 += 2) {
#pragma unroll
                    for (int cc = 0; cc < 2; ++cc) { const int c = c2 + cc;
                        if (cc == 0) { if (c + 1 < NCH) { SCAN_STAGE(c + 1, b); } SCAN_LOAD(c + 3, b); } else { if (c + 1 < NCH) { SCAN_STAGE(c + 1, a); } SCAN_LOAD(c + 3, a); }
                        if (c > 0) { SCAN_YOUT(c - 1); }
                        { const int gi = conv_first + n_conv * conv_stride, gj = gi + 2 * conv_stride; const int gjc = gj < conv_last ? gj : conv_last; const bool live = gi < N_CONV_IN;
                            if (cc == 0) { if (live) CONV_FINISH(gi, cva); CONV_ISSUE(gjc, cva); } else { if (live) CONV_FINISH(gi, cvb); CONV_ISSUE(gjc, cvb); }
                            n_conv += live ? 1 : 0; }
                        SCAN_BAR();
                    }
                }
                SCAN_YOUT(NCH - 1);
            } else {
                const int rl = lane >> 4, jq = lane & 15, il = 4 * wave + rl;
                f32x2 s01 = (f32x2){0.f, 0.f}, s23 = (f32x2){0.f, 0.f}; float dmy0 = 1.f, dmy1 = 1.f; (void)dmy0; (void)dmy1;
                SCAN_BAR();
                for (int c = 0; c < NCH; ++c) {
                    const LAS float* B_ = SB + (c & 1) * BUF_F + jq * 20; const LAS float* S_ = SB + (c & 1) * BUF_F + OPF;
                    LAS float* yw = (jq == 0) ? (YS + (c & 1) * (TC * 16) + il) : (YDM + lane);
                    f32x4 w4[2], k4[2], b4[2], a4[2], q4[2]; f32x2 vk[2];
#define SLOAD(t) do { const LAS float* o_ = B_ + (t) * 320; w4[(t) & 1] = *(const LAS f32x4*)(o_); k4[(t) & 1] = *(const LAS f32x4*)(o_ + 4); b4[(t) & 1] = *(const LAS f32x4*)(o_ + 8); a4[(t) & 1] = *(const LAS f32x4*)(o_ + 12); q4[(t) & 1] = *(const LAS f32x4*)(o_ + 16); \
        vk[(t) & 1] = *(const LAS f32x2*)(S_ + (t) * 32 + 2 * il); } while (0)
                    SLOAD(0); SLOAD(1);
#pragma unroll
                    for (int t = 0; t < TC; ++t) {
                        const f32x4 cw = w4[t & 1], ck = k4[t & 1], cb = b4[t & 1], ca = a4[t & 1], cq = q4[t & 1]; const f32x2 cvk = vk[t & 1];
                        if (t + 2 < TC) SLOAD(t + 2);
                        f32x2 ta = s01 * (f32x2){ca.x, ca.y}; ta = s23 * (f32x2){ca.z, ca.w} + ta;
                        f32x2 tq = s01 * (f32x2){cq.x, cq.y}; tq = s23 * (f32x2){cq.z, cq.w} + tq;
                        const f32x2 vv2 = (f32x2){cvk.x, cvk.x};
                        const f32x2 vk01 = vv2 * (f32x2){ck.x, ck.y}, vk23 = vv2 * (f32x2){ck.z, ck.w};
                        float psa = ta.x + ta.y, py = tq.x + tq.y;
                        psa += dpp_f(psa, 0); py += dpp_f(py, 0); psa += dpp_f(psa, 1); py += dpp_f(py, 1); psa += dpp_f(psa, 2); py += dpp_f(py, 2); psa += dpp_f(psa, 3); py += dpp_f(py, 3);
                        const float y = py + cvk.y;
                        const f32x2 sa2 = (f32x2){psa, psa};
                        s01 = s01 * (f32x2){cw.x, cw.y} + (sa2 * (f32x2){cb.x, cb.y} + vk01);
                        s23 = s23 * (f32x2){cw.z, cw.w} + (sa2 * (f32x2){cb.z, cb.w} + vk23);
                        yw[t * 16] = y;
                    }
#undef SLOAD
                    SCAN_BAR();
                }
            }
            SCAN_BAR();
        }
        if (wave >= 4) {
            for (int r = 0; r < 2; ++r) { const int gi = conv_first + n_conv * conv_stride; if (gi < N_CONV_IN) { if (n_conv & 1) CONV_FINISH(gi, cvb); else CONV_FINISH(gi, cva); ++n_conv; } }
            for (;;) { const int gi = conv_first + n_conv * conv_stride; if (gi >= N_CONV) break; CONV_ISSUE(gi, cva); CONV_FINISH(gi, cva); ++n_conv; } }
#undef SCAN_LOAD
#undef SCAN_STAGE
#undef SCAN_YOUT
#undef CONV_SRC
#undef CONV_ISSUE
#undef CONV_FINISH
#undef SCAN_BAR
        SEAM();
    }

    if (IN(6)) { PH_BEGIN();
        float lam;
        { const float a1 = INP(5)[lane] * INP(6)[lane], a2 = INP(7)[lane] * INP(8)[lane]; lam = __expf(wave_sum(a1)) - __expf(wave_sum(a2)) + 0.2f; }
        const float* sg = INP(9); const float* lng = INP(19); const float* lnb = INP(20);
        float sgl[16], lgl[16], lbl[16];
#pragma unroll
        for (int i = 0; i < 16; ++i) { sgl[i] = sg[16 * (lane & 7) + i] * 0.8f; lgl[i] = lng[16 * lane + i]; lbl[i] = lnb[16 * lane + i]; }
        for (int m = gw; m < T_; m += NGW) {
            {
                const int h = lane >> 3; const bfu* p0 = Ob + (size_t)m * 2048 + (2 * h) * 128 + 16 * (lane & 7); const bfu* p1 = p0 + 128;
                float o0[16], o1[16]; unpack16(*(const GAS v4u*)p0, *(const GAS v4u*)(p0 + 8), o0); unpack16(*(const GAS v4u*)p1, *(const GAS v4u*)(p1 + 8), o1);
                float ss = 0.f;
#pragma unroll
                for (int i = 0; i < 16; ++i) { o0[i] = o0[i] - lam * o1[i]; ss += o0[i] * o0[i]; }
                ss = oct_sum(ss);
                const float rstd = 1.0f / sqrtf(ss * (1.f / 128.f) + 1e-5f);
#pragma unroll
                for (int i = 0; i < 16; ++i) o0[i] = o0[i] * rstd * sgl[i];
                if (PROJ_F8) { v4u o8; o8.x = pk4f8c(o0[0] * SA_Y, o0[1] * SA_Y, o0[2] * SA_Y, o0[3] * SA_Y); o8.y = pk4f8c(o0[4] * SA_Y, o0[5] * SA_Y, o0[6] * SA_Y, o0[7] * SA_Y); o8.z = pk4f8c(o0[8] * SA_Y, o0[9] * SA_Y, o0[10] * SA_Y, o0[11] * SA_Y); o8.w = pk4f8c(o0[12] * SA_Y, o0[13] * SA_Y, o0[14] * SA_Y, o0[15] * SA_Y);
                    *(GAS v4u*)((unsigned char*)YAb + (size_t)m * 1024 + 16 * lane) = o8; }
                else { v4u oa, ob; pack16(o0, oa, ob); bfu* po = YAb + (size_t)m * 1024 + 16 * lane; *(GAS v4u*)po = oa; *(GAS v4u*)(po + 8) = ob; }
            }
            {
                const float* yp = Yf + (size_t)m * 1024 + 16 * lane; float y[16];
#pragma unroll
                for (int i = 0; i < 4; ++i) { const f32x4 t = *(const GAS f32x4*)(yp + 4 * i); y[4 * i] = t.x; y[4 * i + 1] = t.y; y[4 * i + 2] = t.z; y[4 * i + 3] = t.w; }
#ifdef DBG_Y0
#pragma unroll
                for (int i = 0; i < 16; ++i) y[i] = (float)((i * 7 + lane) & 15) * 0.1f;
#endif
                float s = 0.f;
#pragma unroll
                for (int i = 0; i < 16; ++i) s += y[i];
                const float mean = quad_sum(s) * (1.f / 64.f); float q = 0.f;
#pragma unroll
                for (int i = 0; i < 16; ++i) { y[i] -= mean; q += y[i] * y[i]; }
                const float rstd = 1.0f / sqrtf(quad_sum(q) * (1.f / 64.f) + 64e-5f);
#ifdef DBG_BON0
                float bon; { const bfu* pa = ASb + (size_t)m * 1024 + 16 * lane; float aa[16]; unpack16(*(const GAS v4u*)pa, *(const GAS v4u*)(pa + 8), aa); float sa_ = 0.f;
#pragma unroll
                  for (int i = 0; i < 16; ++i) sa_ += aa[i] * (float)(i + 1); bon = quad_sum(sa_) * 0.01f; }
#else
                const float bon = BON[(size_t)m * 16 + (lane >> 2)];
#endif
                float vv[16], gg[16]; const bfu* pv = VSb + (size_t)m * 1024 + 16 * lane; const bfu* pg = GGb + (size_t)m * 1024 + 16 * lane;
                unpack16(*(const GAS v4u*)pv, *(const GAS v4u*)(pv + 8), vv); unpack16(*(const GAS v4u*)pg, *(const GAS v4u*)(pg + 8), gg);
#pragma unroll
                for (int i = 0; i < 16; ++i) y[i] = (y[i] * rstd * lgl[i] + lbl[i] + bon * vv[i]) * gg[i];
                if (PROJ_F8) { v4u o8; o8.x = pk4f8c(y[0] * SA_Y, y[1] * SA_Y, y[2] * SA_Y, y[3] * SA_Y); o8.y = pk4f8c(y[4] * SA_Y, y[5] * SA_Y, y[6] * SA_Y, y[7] * SA_Y); o8.z = pk4f8c(y[8] * SA_Y, y[9] * SA_Y, y[10] * SA_Y, y[11] * SA_Y); o8.w = pk4f8c(y[12] * SA_Y, y[13] * SA_Y, y[14] * SA_Y, y[15] * SA_Y);
                    *(GAS v4u*)((unsigned char*)YBb + (size_t)m * 1024 + 16 * lane) = o8; }
                else { v4u oa, ob; pack16(y, oa, ob); bfu* po = YBb + (size_t)m * 1024 + 16 * lane; *(GAS v4u*)po = oa; *(GAS v4u*)(po + 8) = ob; }
            }
        }
        SEAM();
    }

    if (IN(7)) { PH_BEGIN();
#if PROJ_F8
        { pg8::Gemm g{YAb, WPAt, 512, 512}; pg8::StaticOrder S; S.init(T_, 2048, G, bx); pg8::EpiProj<0> E{Gb, 0, TMPb, MRGb, 1.0f, 1.0f / (SA_Y * SB_W)};
          pg8::gemm_phase8<pg8::EpiProj<0>, pg8::StaticOrder, true, true>(L + RING_OFF, g, S, E); }
        { pg8::Gemm g{YBb, WPBt, 512, 512}; pg8::StaticOrder S; S.init(T_, 2048, G, bx); pg8::EpiProj<1> E{Gb, 2048, TMPb, MRGb, WOUT_F8 ? SA_M : 1.0f, 1.0f / (SA_Y * SB_W)};
          pg8::gemm_phase8<pg8::EpiProj<1>, pg8::StaticOrder, true, true>(L + RING_OFF, g, S, E); }
#else
        { pg8::Gemm g{YAb, WPAt, 1024, 1024}; pg8::StaticOrder S; S.init(T_, 2048, G, bx); pg8::EpiProj<0> E{Gb, 0, TMPb, MRGb, 1.0f, 1.0f};
          pg8::gemm_phase<pg8::EpiProj<0>, pg8::StaticOrder, true, true>(L + RING_OFF, g, S, E); }
        { pg8::Gemm g{YBb, WPBt, 1024, 1024}; pg8::StaticOrder S; S.init(T_, 2048, G, bx); pg8::EpiProj<1> E{Gb, 2048, TMPb, MRGb, WOUT_F8 ? SA_M : 1.0f, 1.0f};
          pg8::gemm_phase<pg8::EpiProj<1>, pg8::StaticOrder, true, true>(L + RING_OFF, g, S, E); }
#endif
        SEAM();
    }

    if (IN(8)) { PH_BEGIN();
        pg8::Gemm g{MRGb, WOUTt, 2048, 2048}; pg8::StaticOrder S; S.init(T_, 2048, G, bx); pg8::EpiBf16 E{DELTAb, 2048, 1.0f};
        pg8::gemm_phase<pg8::EpiBf16, pg8::StaticOrder, true, true>(L + RING_OFF, g, S, E);
        SEAM();
    }

#define TT ((LAS int*)(L + TT_OFF))
#define TB_BASE ((LAS int*)(L + TT_OFF + 1024))
    if (IN(9)) { PH_BEGIN();
        LAS float* LG = (LAS float*)(L + RING_OFF);
        LAS float* RS = (LAS float*)(L + RING_OFF + 12288);
        LAS unsigned* hist = (LAS unsigned*)(L + RING_OFF + 16384);
        const float* xin = INP(0); const float* bg = INP(26); const float* be = INP(28);
        for (int tb = vcu; tb < 256; tb += G) {
            if (tid < 32) hist[tid] = 0u;
            __syncthreads();
            int e1 = 0, e2 = 0; unsigned q1 = 0u, q2 = 0u; float gt1 = 0.f, gt2 = 0.f;
            if (wave < 4) {
                const int r = lane & 15, q = lane >> 4; const int tok = tb * 64 + wave * 16 + r;
                const float* xr = xin + (size_t)tok * 2048 + 8 * q; const bfu* dr = DELTAb + (size_t)tok * 2048 + 8 * q; bfu* ur = Hb + (size_t)tok * 2048 + 8 * q;
                const bfu* rt = WRTt + (size_t)r * 2048 + 8 * q;
                f32x4 acc0 = (f32x4){0.f, 0.f, 0.f, 0.f}, acc1 = acc0, acc2 = acc0; float ss = 0.f;
#pragma unroll 4
                for (int s = 0; s < 64; ++s) {
                    const f32x4 xa = *(const GAS f32x4*)(xr + 32 * s), xb = *(const GAS f32x4*)(xr + 32 * s + 4); const v4u dd = *(const GAS v4u*)(dr + 32 * s);
                    const v4u b0 = *(const GAS v4u*)(rt + 32 * s), b1 = *(const GAS v4u*)(rt + 16 * 2048 + 32 * s), b2 = *(const GAS v4u*)(rt + 32 * 2048 + 32 * s);
                    float x[8];
                    x[0] = xa.x + bfl(dd.x); x[1] = xa.y + bfh(dd.x); x[2] = xa.z + bfl(dd.y); x[3] = xa.w + bfh(dd.y); x[4] = xb.x + bfl(dd.z); x[5] = xb.y + bfh(dd.z); x[6] = xb.z + bfl(dd.w); x[7] = xb.w + bfh(dd.w);
#pragma unroll
                    for (int i = 0; i < 8; ++i) ss += x[i] * x[i];
                    v4u u; u.x = pk2(x[0], x[1]); u.y = pk2(x[2], x[3]); u.z = pk2(x[4], x[5]); u.w = pk2(x[6], x[7]);
                    *(GAS v4u*)(ur + 32 * s) = u;
                    const bf16x8 af = __builtin_bit_cast(bf16x8, u);
                    acc0 = __builtin_amdgcn_mfma_f32_16x16x32_bf16(af, __builtin_bit_cast(bf16x8, b0), acc0, 0, 0, 0);
                    acc1 = __builtin_amdgcn_mfma_f32_16x16x32_bf16(af, __builtin_bit_cast(bf16x8, b1), acc1, 0, 0, 0);
                    acc2 = __builtin_amdgcn_mfma_f32_16x16x32_bf16(af, __builtin_bit_cast(bf16x8, b2), acc2, 0, 0, 0);
                }
                ss += __shfl_xor(ss, 16); ss += __shfl_xor(ss, 32);
                const float rstd = 1.0f / sqrtf(ss * (1.f / 2048.f) + 1e-6f);
                if (q == 0) { RSTD[tok] = rstd; RS[wave * 16 + r] = rstd; }
                LDS_WAIT(); asm volatile("" ::: "memory");
                LAS float* lgw = LG + wave * (16 * 48);
#pragma unroll
                for (int i = 0; i < 4; ++i) { const float rs_ = RS[wave * 16 + 4 * q + i]; lgw[(4 * q + i) * 48 + r] = acc0[i] * rs_; lgw[(4 * q + i) * 48 + 16 + r] = acc1[i] * rs_; lgw[(4 * q + i) * 48 + 32 + r] = acc2[i] * rs_; }
                LDS_WAIT(); asm volatile("" ::: "memory");
                if (lane < 16) {
                    const LAS float* lr = lgw + lane * 48; float lg[36];
#pragma unroll
                    for (int c4 = 0; c4 < 9; ++c4) { const f32x4 t = *(const LAS f32x4*)(lr + 4 * c4); lg[4 * c4] = t.x; lg[4 * c4 + 1] = t.y; lg[4 * c4 + 2] = t.z; lg[4 * c4 + 3] = t.w; }
                    int gi = 0; float gm = lg[0] + bg[0]; float gl[4];
#pragma unroll
                    for (int i = 0; i < 4; ++i) { gl[i] = lg[i] + bg[i]; if (gl[i] > gm) { gm = gl[i]; gi = i; } }
                    float gs = 0.f;
#pragma unroll
                    for (int i = 0; i < 4; ++i) gs += __expf(gl[i] - gm);
                    const float pg = 1.0f / gs;
                    float el[8];
#pragma unroll
                    for (int j = 0; j < 8; ++j) { float v = 0.f;
#pragma unroll
                        for (int gg = 0; gg < 4; ++gg) v = (gg == gi) ? (lg[4 + gg * 8 + j] + be[gg * 8 + j]) : v;
                        el[j] = v; }
                    int i1 = 0; float m1 = el[0];
#pragma unroll
                    for (int j = 1; j < 8; ++j) if (el[j] > m1) { m1 = el[j]; i1 = j; }
                    int i2 = -1; float m2 = -INFINITY;
#pragma unroll
                    for (int j = 0; j < 8; ++j) if (j != i1 && el[j] > m2) { m2 = el[j]; i2 = j; }
                    const float p2 = __expf(m2 - m1); gt1 = pg / (1.0f + p2); gt2 = pg * p2 / (1.0f + p2);
                    e1 = gi * 8 + i1; e2 = gi * 8 + i2;
                    q1 = atomicAdd((unsigned*)(hist + e1), 1u); q2 = atomicAdd((unsigned*)(hist + e2), 1u);
                    const int tk = tb * 64 + wave * 16 + lane;
                    ASG_E[2 * tk] = e1; ASG_E[2 * tk + 1] = e2; ASG_POS[2 * tk] = (int)q1; ASG_POS[2 * tk + 1] = (int)q2; ASG_GATE[2 * tk] = gt1; ASG_GATE[2 * tk + 1] = gt2;
                }
            }
            __syncthreads();
            if (tid < 32) CNTT[tb * 32 + tid] = (int)hist[tid];
            __syncthreads();
        }
        SEAM();
    }

#define MOE_TABLES(tbsel) do { LAS int* tot_ = (LAS int*)(L + TT_OFF + 1280); \
        if (tid < 32) { int run = 0, mine = 0; _Pragma("unroll 8") for (int t2 = 0; t2 < 256; ++t2) { if (t2 == (tbsel)) mine = run; run += CNTT[t2 * 32 + tid]; } tot_[tid] = run; TB_BASE[tid] = mine; } \
        __syncthreads(); \
        if (tid == 0) { int off = 0, nt = 0; for (int e = 0; e < 32; ++e) { const int c = tot_[e]; TT[e] = off; const int n = (c + 255) >> 8; for (int k = 0; k < n; ++k) TT[33 + nt + k] = e; nt += n; off += n * 256; } TT[32] = nt; } \
        __syncthreads(); } while (0)
    if (IN(10)) { PH_BEGIN();
        float g2a[16], g2b[16]; { const float* g2p = INP(24) + 32 * lane;
#pragma unroll
            for (int i = 0; i < 16; ++i) { g2a[i] = g2p[i] * SA_H; g2b[i] = g2p[16 + i] * SA_H; } }
        for (int tb = vcu; tb < 256; tb += G) {
            MOE_TABLES(tb);
            const int my_a = tb * 128 + wave * 16 + (lane & 15);
            const int my_e = ASG_E[my_a], my_lp = ASG_POS[my_a]; const float my_gate = ASG_GATE[my_a], my_rs = RSTD[my_a >> 1];
            const int my_dest = TT[my_e] + TB_BASE[my_e] + my_lp;
            if (lane < 16) { ROWGATE[my_dest] = my_gate; TOKDEST[my_a] = my_dest; }
#pragma unroll 4
            for (int i = 0; i < 16; ++i) { const int t = (tb * 128 + wave * 16 + i) >> 1; const int dest = __shfl(my_dest, i); const float sc = __shfl(my_rs, i);
                const GAS v4u* src = (const GAS v4u*)(Hb + (size_t)t * 2048 + 32 * lane); GAS v4u* dst = (GAS v4u*)((unsigned char*)XGb + (size_t)dest * 2048 + 32 * lane);
                float xa[16], xb[16]; unpack16(src[0], src[1], xa); unpack16(src[2], src[3], xb);
#pragma unroll
                for (int j = 0; j < 16; ++j) { xa[j] *= g2a[j]; xb[j] *= g2b[j]; }
                v4u o0, o1;
                o0.x = pk4f8c(xa[0] * sc, xa[1] * sc, xa[2] * sc, xa[3] * sc); o0.y = pk4f8c(xa[4] * sc, xa[5] * sc, xa[6] * sc, xa[7] * sc);
                o0.z = pk4f8c(xa[8] * sc, xa[9] * sc, xa[10] * sc, xa[11] * sc); o0.w = pk4f8c(xa[12] * sc, xa[13] * sc, xa[14] * sc, xa[15] * sc);
                o1.x = pk4f8c(xb[0] * sc, xb[1] * sc, xb[2] * sc, xb[3] * sc); o1.y = pk4f8c(xb[4] * sc, xb[5] * sc, xb[6] * sc, xb[7] * sc);
                o1.z = pk4f8c(xb[8] * sc, xb[9] * sc, xb[10] * sc, xb[11] * sc); o1.w = pk4f8c(xb[12] * sc, xb[13] * sc, xb[14] * sc, xb[15] * sc);
                dst[0] = o0; dst[1] = o1; }
            __syncthreads();
        }
        SEAM();
    }

    if (IN(11)) { PH_BEGIN();
        if (lo == 11) MOE_TABLES(-1);
        const int ntiles = __builtin_amdgcn_readfirstlane(TT[32]);
        pg8::Gemm g{XGb, WGUt, 1024, 1024}; pg8::MoeOrder S; S.so.init(ntiles * 256, 2048, G, bx); S.tile_e = (const LAS int*)(TT + 33); pg8::EpiGU E{(unsigned char*)ACTb, 1.0f / (SA_H * SB_W), SA_ACT};
        pg8::gemm_phase8<pg8::EpiGU, pg8::MoeOrder, true, true>(L + RING_OFF, g, S, E);
        SEAM();
    }
    if (IN(12)) { PH_BEGIN();
        if (lo == 12) MOE_TABLES(-1);
        const int ntiles = __builtin_amdgcn_readfirstlane(TT[32]);
        pg8::Gemm g{ACTb, WDt, 512, 512}; pg8::MoeOrder S; S.so.init(ntiles * 256, 2048, G, bx); S.tile_e = (const LAS int*)(TT + 33); pg8::EpiDown E{YDb, ROWGATE, 1.0f / (SA_ACT * SB_W)};
        pg8::gemm_phase8<pg8::EpiDown, pg8::MoeOrder, true, true>(L + RING_OFF, g, S, E);
        SEAM();
    }
    if (IN(13)) { PH_BEGIN();
        int td_ = 0; { const int mi = gw + (lane >> 1) * NGW; if (mi < T_) td_ = TOKDEST[2 * mi + (lane & 1)]; }
        int kk_ = 0;
        for (int m = gw; m < T_; m += NGW, ++kk_) { const int d0 = __shfl(td_, (2 * kk_) & 63), d1 = __shfl(td_, (2 * kk_ + 1) & 63);
            GAS f32x4* o = (GAS f32x4*)(OUTP + (size_t)m * 2048) + lane; const GAS u32x2* dl = (const GAS u32x2*)(Hb + (size_t)m * 2048) + lane;
            const GAS u32x2* y0 = (const GAS u32x2*)(YDb + (size_t)d0 * 2048) + lane; const GAS u32x2* y1 = (const GAS u32x2*)(YDb + (size_t)d1 * 2048) + lane;
#pragma unroll
            for (int j = 0; j < 8; ++j) { const u32x2 a = y0[64 * j], b = y1[64 * j], d = dl[64 * j]; f32x4 v;
                v.x = bfl(d.x) + (bfl(a.x) + bfl(b.x)); v.y = bfh(d.x) + (bfh(a.x) + bfh(b.x)); v.z = bfl(d.y) + (bfl(a.y) + bfl(b.y)); v.w = bfh(d.y) + (bfh(a.y) + bfh(b.y)); o[64 * j] = v; } }
    }
#undef IN
#undef SEAM
}

#ifndef N_PHASES_
#define N_PHASES_ 14
#endif
constexpr int N_PHASES = N_PHASES_;
extern "C" void kernel_launch(void* const* d_in, const int* in_sizes, int n_in, void* d_out, int out_size, void* d_ws, size_t ws_size, hipStream_t stream) {
    static int grid = 0;
    if (grid == 0) {
        if (n_in != 32 || out_size != T_ * DMODEL || ws_size < WS_END) { fprintf(stderr, "kernel_launch: unexpected problem (n_in %d, out %d, ws %zu)\n", n_in, out_size, ws_size); grid = -1; return; }
        int dev = 0, cus = 0, per_cu = 0;
        if (hipGetDevice(&dev) != hipSuccess || hipDeviceGetAttribute(&cus, hipDeviceAttributeMultiprocessorCount, dev) != hipSuccess) { grid = -1; return; }
        if (hipFuncSetAttribute((const void*)mk_fwd, hipFuncAttributeMaxDynamicSharedMemorySize, LDS_BYTES) != hipSuccess) { fprintf(stderr, "kernel_launch: hipFuncSetAttribute failed\n"); grid = -1; return; }
        if (hipOccupancyMaxActiveBlocksPerMultiprocessor(&per_cu, (const void*)mk_fwd, NWAVES * 64, LDS_BYTES) != hipSuccess || per_cu < 1) fprintf(stderr, "kernel_launch: occupancy query reports %d\n", per_cu);
        (void)hipGetLastError();
        grid = cus;
    }
    if (grid < 0) return;
    if (hipMemsetAsync((char*)d_ws + WS_CTL, 0, CTL_ZERO_BYTES, stream) != hipSuccess) return;
    Args a{};
    for (int i = 0; i < 32; ++i) a.in[i] = (const float*)d_in[i];
    a.out = (float*)d_out; a.ws = (unsigned char*)d_ws;
#if defined(DUP_PH)
    { const int cuts[4] = {0, DUP_PH + 1, DUP_PH, N_PHASES}; const int ends[3] = {DUP_PH + 1, DUP_PH + 1, N_PHASES};
      for (int l = 0; l < 3; ++l) { a.ph_lo = cuts[l == 2 ? 1 : (l == 1 ? 2 : 0)]; a.ph_hi = ends[l]; a.li = l; hipLaunchKernelGGL(mk_fwd, dim3(grid), dim3(NWAVES * 64), LDS_BYTES, stream, a); } }
#elif MK_SPLIT
    for (int p = 0; p < N_PHASES; ++p) { a.ph_lo = p; a.ph_hi = p + 1; hipLaunchKernelGGL(mk_fwd, dim3(grid), dim3(NWAVES * 64), LDS_BYTES, stream, a); }
#else
    a.ph_lo = 0; a.ph_hi = N_PHASES; hipLaunchKernelGGL(mk_fwd, dim3(grid), dim3(NWAVES * 64), LDS_BYTES, stream, a);
#endif
}
```
